# Optimizing an MI355X kernel written in HIP

```python
import jax
import jax.numpy as jnp
from jax import lax
import numpy as np

D_MODEL = 4096
BATCH = 32
SEQ = 256
DEPTH = 1
DEC_BATCH = 4
DEC_SEQ = 1024
PAST_LEN = 512

GRID_W = 64
RET_HEADS = 8
RET_DK = D_MODEL // 16
RET_DV = D_MODEL // 16
RET_CHUNK = 128
ATT_HEADS = 16
ATT_KV_HEADS = 4
ATT_GROUPS = ATT_HEADS // ATT_KV_HEADS
ATT_HEAD_DIM = D_MODEL // 32
WINDOW = 128
BLOCK = 128
FFN_HIDDEN = ((8 * D_MODEL + 3 * 256 - 1) // (3 * 256)) * 256
ROPE_BASE = 10000.0
NORM_EPS = 1e-6
NEG_INF = -1e30
RET_QK_W = RET_HEADS * RET_DK
RET_V_W = RET_HEADS * RET_DV
ATT_Q_W = ATT_HEADS * ATT_HEAD_DIM
ATT_KV_W = ATT_KV_HEADS * ATT_HEAD_DIM
IN_SIZES = (RET_QK_W, RET_QK_W, RET_V_W, RET_V_W, ATT_Q_W, ATT_KV_W, ATT_KV_W, D_MODEL, D_MODEL)
IN_COLS = sum(IN_SIZES)

kernel_name = 'hybrid_retention_swa_diffusion_step'


def rmsnorm(x, w):
    x32 = x.astype(jnp.float32)
    y = x32 * lax.rsqrt(jnp.mean(x32 * x32, axis=-1, keepdims=True) + NORM_EPS)
    return (y * w.astype(jnp.float32)).astype(x.dtype)


def adaln_params(cond, w_mod, b_mod):
    return jnp.split(jax.nn.silu(cond) @ w_mod + b_mod, 6, axis=-1)


def modulate(x, shift, scale):
    return x * (1 + scale) + shift


def axial_rope(x):
    length, hd = x.shape[1], x.shape[-1]
    rows = length // GRID_W
    row = jnp.repeat(jnp.arange(rows), GRID_W).astype(jnp.float32)
    col = jnp.tile(jnp.arange(GRID_W), rows).astype(jnp.float32)
    half = hd // 2
    quarter = half // 2
    inv_freq = ROPE_BASE ** (-jnp.arange(quarter, dtype=jnp.float32) / quarter)

    def rotate(xa, pos):
        ang = pos[:, None] * inv_freq[None, :]
        cos = jnp.cos(ang)[None, :, None, :]
        sin = jnp.sin(ang)[None, :, None, :]
        x1, x2 = jnp.split(xa.astype(jnp.float32), 2, axis=-1)
        return jnp.concatenate([x1 * cos - x2 * sin, x1 * sin + x2 * cos], axis=-1)

    return jnp.concatenate([rotate(x[..., :half], row), rotate(x[..., half:], col)], axis=-1).astype(x.dtype)


def in_projection(h, w_in):
    proj = h @ w_in
    parts = []
    off = 0
    for size in IN_SIZES:
        parts.append(proj[..., off:off + size])
        off += size
    return parts


def swiglu(h, w_up, w_down):
    a, b = jnp.split(h @ w_up, 2, axis=-1)
    return (jax.nn.silu(a) * b) @ w_down


def retention_scan(q, k, v, log_gamma, s0):
    bsz, length, heads, _ = q.shape
    n_chunks = length // RET_CHUNK

    def chunks(a):
        return a.astype(jnp.float32).reshape(bsz, n_chunks, RET_CHUNK, heads, a.shape[-1]).transpose(1, 0, 3, 2, 4)

    idx = jnp.arange(RET_CHUNK, dtype=jnp.float32)
    diff = idx[:, None] - idx[None, :]
    d_intra = jnp.where(diff >= 0, jnp.exp(log_gamma[:, None, None] * jnp.maximum(diff, 0.0)), 0.0)
    d_q = jnp.exp(log_gamma[:, None] * (idx + 1.0))[:, :, None]
    d_k = jnp.exp(log_gamma[:, None] * (RET_CHUNK - 1.0 - idx))[:, :, None]
    d_chunk = jnp.exp(log_gamma * RET_CHUNK)[:, None, None]

    def step(state, qkv):
        qc, kc, vc = qkv
        scores = jnp.einsum('bhik,bhjk->bhij', qc, kc) * d_intra
        o = jnp.einsum('bhij,bhjv->bhiv', scores, vc) + jnp.einsum('bhik,bhkv->bhiv', qc * d_q, state)
        state = state * d_chunk + jnp.einsum('bhjk,bhjv->bhkv', kc * d_k, vc)
        return state, o

    s_final, out = lax.scan(step, s0.astype(jnp.float32), (chunks(q), chunks(k), chunks(v)))
    out = out.transpose(1, 0, 3, 2, 4).reshape(bsz, length, heads, v.shape[-1])
    return out, s_final


def retention_branch(rq, rk, rv, rg, log_decay_fwd, log_decay_bwd, gn_w, s0_fwd, s0_bwd, use_rope):
    bsz, length = rq.shape[:2]
    q = rq.reshape(bsz, length, RET_HEADS, RET_DK)
    k = rk.reshape(bsz, length, RET_HEADS, RET_DK) * (RET_DK ** -0.5)
    v = rv.reshape(bsz, length, RET_HEADS, RET_DV)
    if use_rope:
        q = axial_rope(q)
        k = axial_rope(k)
    log_gamma_f = -jnp.exp(log_decay_fwd.astype(jnp.float32))
    log_gamma_b = -jnp.exp(log_decay_bwd.astype(jnp.float32))
    o_f, s_f = retention_scan(q, k, v, log_gamma_f, s0_fwd)
    o_b, s_b = retention_scan(q[:, ::-1], k[:, ::-1], v[:, ::-1], log_gamma_b, s0_bwd)
    o = o_f + o_b[:, ::-1]
    o = o * lax.rsqrt(jnp.mean(o * o, axis=-1, keepdims=True) + NORM_EPS)
    o = o.reshape(bsz, length, RET_V_W) * gn_w.astype(jnp.float32)
    return jax.nn.silu(rg) * o.astype(rg.dtype), s_f, s_b


def sink_attention(qb, parts, sink):
    bsz, nq = qb.shape[:2]
    scores = []
    for k, v, mask in parts:
        s = jnp.einsum('bqhgd,bkhd->bhgqk', qb, k).astype(jnp.float32)
        if mask is not None:
            s = jnp.where(mask, s, NEG_INF)
        scores.append(s)
    sink_col = jnp.broadcast_to(sink.astype(jnp.float32).reshape(ATT_KV_HEADS, ATT_GROUPS, 1, 1), (bsz, ATT_KV_HEADS, ATT_GROUPS, nq, 1))
    probs = jax.nn.softmax(jnp.concatenate(scores + [sink_col], axis=-1), axis=-1)
    out = None
    off = 0
    for k, v, mask in parts:
        n_keys = k.shape[1]
        o = jnp.einsum('bhgqk,bkhd->bqhgd', probs[..., off:off + n_keys].astype(v.dtype), v)
        out = o if out is None else out + o
        off += n_keys
    return out


def context_attention(q, k, v, sink):
    bsz, length = q.shape[:2]
    n_blocks = length // BLOCK

    def block(n):
        qb = lax.dynamic_slice_in_dim(q, n * BLOCK, BLOCK, axis=1)
        return sink_attention(qb, [(k, v, None)], sink)

    out = lax.map(block, jnp.arange(n_blocks))
    return jnp.moveaxis(out, 0, 1).reshape(bsz, length, ATT_Q_W)


def windowed_attention(q, k, v, k_ctx, v_ctx, sink):
    bsz, length = q.shape[:2]
    n_blocks = length // BLOCK
    pad = ((0, 0), (BLOCK, BLOCK), (0, 0), (0, 0))
    kp = jnp.pad(k, pad)
    vp = jnp.pad(v, pad)
    qi = jnp.arange(BLOCK)
    kj = jnp.arange(3 * BLOCK)

    def block(n):
        qb = lax.dynamic_slice_in_dim(q, n * BLOCK, BLOCK, axis=1)
        kw = lax.dynamic_slice_in_dim(kp, n * BLOCK, 3 * BLOCK, axis=1)
        vw = lax.dynamic_slice_in_dim(vp, n * BLOCK, 3 * BLOCK, axis=1)
        qpos = n * BLOCK + qi
        kpos = (n - 1) * BLOCK + kj
        mask = (jnp.abs(kpos[None, :] - qpos[:, None]) <= WINDOW) & (kpos >= 0)[None, :] & (kpos < length)[None, :]
        return sink_attention(qb, [(kw, vw, mask), (k_ctx, v_ctx, None)], sink)

    out = lax.map(block, jnp.arange(n_blocks))
    return jnp.moveaxis(out, 0, 1).reshape(bsz, length, ATT_Q_W)


def merge_branches(ret_out, att_out, gr, ga, w_branch_ret, w_branch_att, w_out):
    mix = jax.nn.sigmoid(gr) * (ret_out @ w_branch_ret) + jax.nn.sigmoid(ga) * (att_out @ w_branch_att)
    return mix @ w_out


def finish_layer(x, mix, mods, lw):
    x = x + mods[2] * rmsnorm(mix, lw['norm_mix_post'])
    h = modulate(rmsnorm(x, lw['norm_ffn_pre']), mods[3], mods[4])
    return x + mods[5] * rmsnorm(swiglu(h, lw['w_ffn_up'], lw['w_ffn_down']), lw['norm_ffn_post'])


def context_layer(x, mods, lw):
    bsz, length = x.shape[:2]
    h = modulate(rmsnorm(x, lw['norm_mix_pre']), mods[0], mods[1])
    rq, rk, rv, rg, aq, ak, av, gr, ga = in_projection(h, lw['w_in'])
    zeros = jnp.zeros((bsz, RET_HEADS, RET_DK, RET_DV), jnp.float32)
    ret_out, s_f, s_b = retention_branch(rq, rk, rv, rg, lw['ret_log_decay_fwd'], lw['ret_log_decay_bwd'], lw['ret_gn_w'], zeros, zeros, False)
    q = aq.reshape(bsz, length, ATT_KV_HEADS, ATT_GROUPS, ATT_HEAD_DIM) * (ATT_HEAD_DIM ** -0.5)
    k = ak.reshape(bsz, length, ATT_KV_HEADS, ATT_HEAD_DIM)
    v = av.reshape(bsz, length, ATT_KV_HEADS, ATT_HEAD_DIM)
    att_out = context_attention(q, k, v, lw['att_sink'])
    mix = merge_branches(ret_out, att_out, gr, ga, lw['w_branch_ret'], lw['w_branch_att'], lw['w_out'])
    return finish_layer(x, mix, mods, lw), k, v, s_f, s_b


def latent_layer(x, mods, k_ctx, v_ctx, s_ctx_fwd, s_ctx_bwd, lw):
    bsz, length = x.shape[:2]
    h = modulate(rmsnorm(x, lw['norm_mix_pre']), mods[0], mods[1])
    rq, rk, rv, rg, aq, ak, av, gr, ga = in_projection(h, lw['w_in'])
    ret_out, _, _ = retention_branch(rq, rk, rv, rg, lw['ret_log_decay_fwd'], lw['ret_log_decay_bwd'], lw['ret_gn_w'], s_ctx_fwd, s_ctx_bwd, True)
    q = axial_rope(aq.reshape(bsz, length, ATT_HEADS, ATT_HEAD_DIM)) * (ATT_HEAD_DIM ** -0.5)
    q = q.reshape(bsz, length, ATT_KV_HEADS, ATT_GROUPS, ATT_HEAD_DIM)
    k = axial_rope(ak.reshape(bsz, length, ATT_KV_HEADS, ATT_HEAD_DIM))
    v = av.reshape(bsz, length, ATT_KV_HEADS, ATT_HEAD_DIM)
    att_out = windowed_attention(q, k, v, k_ctx.astype(k.dtype), v_ctx.astype(v.dtype), lw['att_sink'])
    mix = merge_branches(ret_out, att_out, gr, ga, lw['w_branch_ret'], lw['w_branch_att'], lw['w_out'])
    return finish_layer(x, mix, mods, lw)


def setup_inputs(seed: int = 0) -> dict:
    key = jax.random.key(seed)
    ks = jax.random.split(key, 24)
    f32 = jnp.float32

    def nrm(k, shape, scale=1.0):
        return jax.random.normal(k, shape, f32) * scale

    decay_base = jnp.asarray(np.log(-np.log1p(-(2.0 ** (-5.0 - np.arange(RET_HEADS))))), f32)
    return {
        'x_prompt': nrm(ks[0], (BATCH, SEQ, D_MODEL)),
        'x_sample': nrm(ks[1], (DEC_BATCH, DEC_SEQ, D_MODEL)),
        'cache_att_k': nrm(ks[2], (DEC_BATCH, DEPTH, PAST_LEN, ATT_KV_HEADS, ATT_HEAD_DIM)),
        'cache_att_v': nrm(ks[3], (DEC_BATCH, DEPTH, PAST_LEN, ATT_KV_HEADS, ATT_HEAD_DIM)),
        'state_ret_fwd': nrm(ks[4], (DEC_BATCH, DEPTH, RET_HEADS, RET_DK, RET_DV), 0.5),
        'state_ret_bwd': nrm(ks[5], (DEC_BATCH, DEPTH, RET_HEADS, RET_DK, RET_DV), 0.5),
        'c': nrm(ks[6], (DEC_BATCH, D_MODEL)),
        'c_ctx': nrm(ks[7], (D_MODEL,)),
        'w_mod': nrm(ks[8], (DEPTH, D_MODEL, 6 * D_MODEL), D_MODEL ** -0.5),
        'b_mod': nrm(ks[9], (DEPTH, 6 * D_MODEL), 0.01),
        'norm_mix_pre': 1.0 + nrm(ks[10], (DEPTH, D_MODEL), 0.05),
        'norm_mix_post': 1.0 + nrm(ks[11], (DEPTH, D_MODEL), 0.05),
        'norm_ffn_pre': 1.0 + nrm(ks[12], (DEPTH, D_MODEL), 0.05),
        'norm_ffn_post': 1.0 + nrm(ks[13], (DEPTH, D_MODEL), 0.05),
        'w_in': nrm(ks[14], (DEPTH, D_MODEL, IN_COLS), D_MODEL ** -0.5),
        'ret_log_decay_fwd': decay_base + nrm(ks[15], (DEPTH, RET_HEADS), 0.05),
        'ret_log_decay_bwd': decay_base + nrm(ks[16], (DEPTH, RET_HEADS), 0.05),
        'ret_gn_w': 1.0 + nrm(ks[17], (DEPTH, RET_V_W), 0.05),
        'att_sink': nrm(ks[18], (DEPTH, ATT_HEADS), 0.5),
        'w_branch_ret': nrm(ks[19], (DEPTH, RET_V_W, D_MODEL), RET_V_W ** -0.5),
        'w_branch_att': nrm(ks[20], (DEPTH, ATT_Q_W, D_MODEL), ATT_Q_W ** -0.5),
        'w_out': nrm(ks[21], (DEPTH, D_MODEL, D_MODEL), D_MODEL ** -0.5),
        'w_ffn_up': nrm(ks[22], (DEPTH, D_MODEL, 2 * FFN_HIDDEN), D_MODEL ** -0.5),
        'w_ffn_down': nrm(ks[23], (DEPTH, FFN_HIDDEN, D_MODEL), FFN_HIDDEN ** -0.5),
    }


def reference(x_prompt, x_sample, cache_att_k, cache_att_v, state_ret_fwd, state_ret_bwd, c, c_ctx,
              w_mod, b_mod, norm_mix_pre, norm_mix_post, norm_ffn_pre, norm_ffn_post, w_in,
              ret_log_decay_fwd, ret_log_decay_bwd, ret_gn_w, att_sink, w_branch_ret, w_branch_att,
              w_out, w_ffn_up, w_ffn_down):
    y_prompt = x_prompt
    y_sample = x_sample
    ks_out, vs_out, sf_out, sb_out = [], [], [], []
    for l in range(DEPTH):
        lw = {
            'norm_mix_pre': norm_mix_pre[l], 'norm_mix_post': norm_mix_post[l],
            'norm_ffn_pre': norm_ffn_pre[l], 'norm_ffn_post': norm_ffn_post[l],
            'w_in': w_in[l], 'ret_log_decay_fwd': ret_log_decay_fwd[l], 'ret_log_decay_bwd': ret_log_decay_bwd[l],
            'ret_gn_w': ret_gn_w[l], 'att_sink': att_sink[l], 'w_branch_ret': w_branch_ret[l],
            'w_branch_att': w_branch_att[l], 'w_out': w_out[l], 'w_ffn_up': w_ffn_up[l], 'w_ffn_down': w_ffn_down[l],
        }
        mods_ctx = adaln_params(c_ctx, w_mod[l], b_mod[l])
        mods_lat = [m[:, None, :] for m in adaln_params(c, w_mod[l], b_mod[l])]
        y_prompt, k_l, v_l, sf_l, sb_l = context_layer(y_prompt, mods_ctx, lw)
        ks_out.append(k_l)
        vs_out.append(v_l)
        sf_out.append(sf_l)
        sb_out.append(sb_l)
        y_sample = latent_layer(y_sample, mods_lat, cache_att_k[:, l], cache_att_v[:, l],
                                state_ret_fwd[:, l], state_ret_bwd[:, l], lw)
    new_att_k = jnp.stack(ks_out, axis=1)
    new_att_v = jnp.stack(vs_out, axis=1)
    new_ret_fwd = jnp.stack(sf_out, axis=1)
    new_ret_bwd = jnp.stack(sb_out, axis=1)
    return (y_prompt, y_sample, new_att_k, new_att_v, new_ret_fwd, new_ret_bwd)
```

```cpp
#include <hip/hip_runtime.h>
#include <cstdio>
#include <cstdint>
namespace pg8 {
#define PG8_LAS __attribute__((address_space(3)))
typedef unsigned short bf16_t;
typedef short bf16x8 __attribute__((ext_vector_type(8)));
typedef float f32x4 __attribute__((ext_vector_type(4)));
typedef unsigned u32x4 __attribute__((ext_vector_type(4)));
constexpr int BM = 256, BK = 64, HALF = 128, HTB = HALF * BK * 2  , STAGE_BYTES = 8 * HTB, NXCD = 8, WGM = 8;

__host__ __device__ __forceinline__ int lds_byte(int r, int c) { const int st = (r >> 4) * 2 + (c >> 5), rr = r & 15, cc = c & 31, ob = rr * 64 + cc * 2; return st * 1024 + (ob ^ (((ob >> 9) & 1) << 5)); }
__host__ __device__ __forceinline__ void stage_rc(int b, int& R, int& C) { const int st = b / 1024, sb = b % 1024, swz = sb ^ (((sb >> 9) & 1) << 5); R = (st >> 1) * 16 + swz / 64; C = (st & 1) * 32 + (swz % 64) / 2; }
__host__ __device__ __forceinline__ int perm32(int rho) { const int n = rho >> 4, i = rho & 15; return 8 * (i >> 2) + 4 * n + (i & 3); }

struct Unit { int pm, pn; };
struct Gemm { const bf16_t* A; const bf16_t* Bt; int M, N, K; };

struct StaticOrder {
    int nM, nN, nwg, G, c;
    __host__ __device__ void init(int M, int N, int G_, int c_) { nM = M / BM; nN = N / BM; nwg = nM * nN; G = G_; c = c_; }
    __host__ __device__ bool next(int i, Unit& u) const {
        const long L = (long)i * G + c; if (L >= nwg) return false;
        int wgid = (int)L; { const int q = nwg / NXCD, r = nwg % NXCD, xcd = wgid % NXCD, off = wgid / NXCD; wgid = (xcd < r ? xcd * (q + 1) : r * (q + 1) + (xcd - r) * q) + off; }
        const int nig = WGM * nN, gid = wgid / nig, fm = gid * WGM, gsz = (nM - fm) < WGM ? (nM - fm) : WGM;
        u.pm = fm + ((wgid % nig) % gsz); u.pn = (wgid % nig) / gsz; return true;
    }
    __device__ __forceinline__ void a_ready(const Unit&) const {}
    __device__ __forceinline__ void done(const Unit&) const {}
};

__device__ __forceinline__ unsigned cvt_pk_bf16(float lo, float hi) { unsigned r; asm volatile("v_cvt_pk_bf16_f32 %0, %1, %2" : "=v"(r) : "v"(lo), "v"(hi)); return r; }
typedef float f32x2 __attribute__((ext_vector_type(2)));
__device__ __forceinline__ f32x2 gelu_pk(f32x2 v) {
    const f32x2 av = __builtin_elementwise_abs(v), d = av * 0.2316418882f + 1.0f;
    f32x2 t; t.x = __builtin_amdgcn_rcpf(d.x); t.y = __builtin_amdgcn_rcpf(d.y);
    f32x2 q = t * 0.5307027145f + (-0.7265760135f); q = q * t + 0.7107068705f; q = q * t + (-0.142248368f); q = q * t + 0.127414796f; q = q * t;
    const f32x2 s = (v * v) * (-0.72134752044f);
    f32x2 e; e.x = __builtin_amdgcn_exp2f(s.x); e.y = __builtin_amdgcn_exp2f(s.y);
    const f32x2 m = v * (q * e), r = v - m;
    f32x2 o; o.x = v.x < 0.f ? m.x : r.x; o.y = v.y < 0.f ? m.y : r.y; return o;
}

template <int ACT  > struct EpiBf16 {
    static constexpr bool PERM = true, AFTER_DRAIN = false; static_assert(ACT == 0 || ACT == 1, "EpiBf16: ACT is 0 (none) or 1 (gelu_pk)");
    bf16_t* O; int ldc; const float* bias; int split_cols; size_t split_stride; float scale0;
    __device__ __forceinline__ void operator()(const f32x4 (&acc)[2][2][4][2], const Unit& u, int wr, int wc, int fr, int fq) const {
        const int row0 = u.pm * BM + wr * 64 + fr; int colt = u.pn * BM; bf16_t* base = O;
        float sc = 1.f; if (split_cols) { const int t = colt / split_cols; base += (size_t)t * split_stride; colt -= t * split_cols; if (t == 0) sc = scale0; }
        const int col0 = colt + wc * 32 + 8 * fq, bcol0 = u.pn * BM + wc * 32 + 8 * fq;
        f32x4 bv[2][2];
#pragma unroll
        for (int bj = 0; bj < 2; ++bj)
#pragma unroll
            for (int n = 0; n < 2; ++n) bv[bj][n] = bias ? *(const f32x4*)(bias + bcol0 + bj * HALF + 4 * n) : (f32x4){0.f, 0.f, 0.f, 0.f};
#pragma unroll
        for (int ai = 0; ai < 2; ++ai)
#pragma unroll
            for (int m = 0; m < 4; ++m) { bf16_t* rowp = base + (size_t)(row0 + ai * HALF + m * 16) * ldc + col0;
#pragma unroll
                for (int bj = 0; bj < 2; ++bj) { f32x4 v0 = acc[ai][bj][m][0] + bv[bj][0], v1 = acc[ai][bj][m][1] + bv[bj][1];
                    if (ACT == 1) { f32x2 a = gelu_pk((f32x2){v0[0], v0[1]}), b = gelu_pk((f32x2){v0[2], v0[3]}), c = gelu_pk((f32x2){v1[0], v1[1]}), d = gelu_pk((f32x2){v1[2], v1[3]});
                        v0 = (f32x4){a.x, a.y, b.x, b.y}; v1 = (f32x4){c.x, c.y, d.x, d.y}; }
                    v0 = v0 * sc; v1 = v1 * sc; u32x4 w; w.x = cvt_pk_bf16(v0[0], v0[1]); w.y = cvt_pk_bf16(v0[2], v0[3]); w.z = cvt_pk_bf16(v1[0], v1[1]); w.w = cvt_pk_bf16(v1[2], v1[3]);
                    *(u32x4*)(rowp + bj * HALF) = w; } }
    }
};
struct EpiF32 {
    static constexpr bool PERM = false, AFTER_DRAIN = false;
    float* C; int ldc;
    __device__ __forceinline__ void operator()(const f32x4 (&acc)[2][2][4][2], const Unit& u, int wr, int wc, int fr, int fq) const {
        const int row0 = u.pm * BM + wr * 64 + fr, col0 = u.pn * BM + wc * 32 + 4 * fq;
#pragma unroll
        for (int ai = 0; ai < 2; ++ai)
#pragma unroll
            for (int m = 0; m < 4; ++m) { float* rowp = C + (size_t)(row0 + ai * HALF + m * 16) * ldc + col0;
#pragma unroll
                for (int bj = 0; bj < 2; ++bj)
#pragma unroll
                    for (int n = 0; n < 2; ++n) *(f32x4*)(rowp + bj * HALF + n * 16) = acc[ai][bj][m][n]; }
    }
};
template <class Epi, class Sched, bool ALIGN_EPI = false, bool SP2 = false>
__device__ __forceinline__ void gemm_phase(PG8_LAS unsigned char* lds, const Gemm g, const Sched& S, const Epi& E) {
    const int tid = threadIdx.x, wid = __builtin_amdgcn_readfirstlane(tid >> 6), lane = tid & 63, wr = wid >> 2, wc = wid & 3, fr = lane & 15, fq = lane >> 4;
    const int K = g.K, nt = K / BK;
    unsigned voffA[2], voffB[2];
#pragma unroll
    for (int i = 0; i < 2; ++i) { int R, C; stage_rc(tid * 16 + i * 8192, R, C); const int Rb = Epi::PERM ? ((R & ~31) + perm32(R & 31)) : R;
        voffA[i] = (unsigned)(R * K + C) * 2u; voffB[i] = (unsigned)(Rb * K + C) * 2u; }
    const size_t kstep = (size_t)(BK * 2);
    const size_t hstep = (size_t)HALF * K * 2;
    const size_t tstep = 2 * hstep;
    const unsigned ldsw = (unsigned)wid * 1024u;
    const int aoff = lds_byte(wr * 64 + fr, fq * 8), boff = lds_byte(wc * 32 + fr, fq * 8);
#define PG8_SA(b, h) (((b) * 2 + (h)) * HTB)
#define PG8_SB(b, h) ((4 + (b) * 2 + (h)) * HTB)
#define PG8_STAGE(bufoff, gbase, voff) do { _Pragma("unroll") for (int _i = 0; _i < 2; ++_i) \
        __builtin_amdgcn_global_load_lds((const unsigned*)((const char*)(gbase) + (voff)[_i]), (PG8_LAS unsigned*)(lds + (bufoff) + ldsw + _i * 8192), 16, 0, 0); } while (0)
#define PG8_LDA(dst, b, h) do { _Pragma("unroll") for (int m = 0; m < 4; ++m) _Pragma("unroll") for (int k = 0; k < 2; ++k) dst[m][k] = *(const PG8_LAS bf16x8*)(lds + PG8_SA(b, h) + aoff + m * 2048 + k * 1024); } while (0)
#define PG8_LDB(dst, b, h) do { _Pragma("unroll") for (int n = 0; n < 2; ++n) _Pragma("unroll") for (int k = 0; k < 2; ++k) dst[n][k] = *(const PG8_LAS bf16x8*)(lds + PG8_SB(b, h) + boff + n * 2048 + k * 1024); } while (0)
#define PG8_MMA(ai, bj, At, Bt) do { __builtin_amdgcn_s_setprio(1); _Pragma("unroll") for (int m = 0; m < 4; ++m) _Pragma("unroll") for (int n = 0; n < 2; ++n) _Pragma("unroll") for (int k = 0; k < 2; ++k) \
        acc[ai][bj][m][n] = __builtin_amdgcn_mfma_f32_16x16x32_bf16(Bt[n][k], At[m][k], acc[ai][bj][m][n], 0, 0, 0); __builtin_amdgcn_s_setprio(0); } while (0)
#define PG8_WAIT_V(n) asm volatile("s_waitcnt vmcnt(" #n ")" ::: "memory")
#define PG8_WAIT_L(n) asm volatile("s_waitcnt lgkmcnt(" #n ")" ::: "memory")
#define PG8_BAR __builtin_amdgcn_s_barrier()
#define PG8_SCHED __builtin_amdgcn_sched_barrier(0)
    Unit cur, nxt; int ui = 0;
    if (!S.next(0, cur)) return;
    f32x4 acc[2][2][4][2];
#pragma unroll
    for (int a = 0; a < 2; ++a)
#pragma unroll
        for (int b = 0; b < 2; ++b)
#pragma unroll
            for (int m = 0; m < 4; ++m)
#pragma unroll
                for (int n = 0; n < 2; ++n) acc[a][b][m][n] = (f32x4){0.f, 0.f, 0.f, 0.f};
    bf16x8 At[4][2], B0[2][2], B1[2][2];
    const char* cA = (const char*)g.A + (size_t)cur.pm * tstep; const char* cB = (const char*)g.Bt + (size_t)cur.pn * tstep;
    S.a_ready(cur);
    if constexpr (SP2) {
        PG8_STAGE(PG8_SB(0, 0), cB, voffB); PG8_STAGE(PG8_SB(0, 1), cB + hstep, voffB); PG8_STAGE(PG8_SA(0, 0), cA, voffA); PG8_STAGE(PG8_SA(0, 1), cA + hstep, voffA);
        if (wr == 1) PG8_BAR;
        PG8_WAIT_V(2); PG8_BAR;
        PG8_STAGE(PG8_SB(1, 0), cB + kstep, voffB); PG8_STAGE(PG8_SA(1, 0), cA + kstep, voffA); PG8_STAGE(PG8_SB(1, 1), cB + hstep + kstep, voffB);
        PG8_WAIT_V(6); PG8_BAR;
    } else {
        PG8_STAGE(PG8_SB(0, 0), cB, voffB); PG8_STAGE(PG8_SA(0, 0), cA, voffA); PG8_STAGE(PG8_SB(0, 1), cB + hstep, voffB); PG8_STAGE(PG8_SA(0, 1), cA + hstep, voffA);
        if (wr == 1) PG8_BAR;
        PG8_WAIT_V(4); PG8_BAR;
        PG8_STAGE(PG8_SB(1, 0), cB + kstep, voffB); PG8_STAGE(PG8_SA(1, 0), cA + kstep, voffA); PG8_STAGE(PG8_SB(1, 1), cB + hstep + kstep, voffB);
        PG8_WAIT_V(6); PG8_BAR;
    }
    for (;;) {
        const bool has_next = S.next(ui + 1, nxt);
        const char* nA = has_next ? (const char*)g.A + (size_t)nxt.pm * tstep : cA; const char* nB = has_next ? (const char*)g.Bt + (size_t)nxt.pn * tstep : cB;
        for (int t = 0; t < nt; t += 2) {
            const bool last = (t == nt - 2);
            const char* a1 = cA + (size_t)(t + 1) * kstep;
            const char* a2 = last ? nA : cA + (size_t)(t + 2) * kstep; const char* b2 = last ? nB : cB + (size_t)(t + 2) * kstep;
            const char* a3 = a2 + kstep; const char* b3 = b2 + kstep;
            if (last && has_next) S.a_ready(nxt);
            if constexpr (SP2) {
            PG8_LDB(B0, 0, 0); PG8_LDB(B1, 0, 1); PG8_SCHED; PG8_LDA(At, 0, 0); PG8_STAGE(PG8_SA(1, 1), a1 + hstep, voffA);
            PG8_WAIT_V(8); PG8_WAIT_L(0); PG8_BAR; PG8_MMA(0, 0, At, B0); PG8_MMA(0, 1, At, B1); PG8_BAR; PG8_SCHED;
            PG8_LDA(At, 0, 1); PG8_STAGE(PG8_SB(0, 0), b2, voffB); PG8_STAGE(PG8_SB(0, 1), b2 + hstep, voffB); PG8_STAGE(PG8_SA(0, 0), a2, voffA);
            PG8_WAIT_V(8); PG8_WAIT_L(0); PG8_BAR; PG8_MMA(1, 0, At, B0); PG8_MMA(1, 1, At, B1); PG8_BAR; PG8_SCHED;
            PG8_LDB(B0, 1, 0); PG8_LDB(B1, 1, 1); PG8_SCHED; PG8_LDA(At, 1, 0); PG8_STAGE(PG8_SA(0, 1), a2 + hstep, voffA);
            PG8_WAIT_V(8); PG8_WAIT_L(0); PG8_BAR; PG8_MMA(0, 0, At, B0); PG8_MMA(0, 1, At, B1); PG8_BAR; PG8_SCHED;
            PG8_LDA(At, 1, 1); PG8_STAGE(PG8_SB(1, 0), b3, voffB); PG8_STAGE(PG8_SB(1, 1), b3 + hstep, voffB); PG8_STAGE(PG8_SA(1, 0), a3, voffA);
            PG8_WAIT_V(8); PG8_WAIT_L(0); PG8_BAR; PG8_MMA(1, 0, At, B0); PG8_MMA(1, 1, At, B1); PG8_BAR; PG8_SCHED;
            } else {
            PG8_LDB(B0, 0, 0); PG8_SCHED; PG8_LDA(At, 0, 0); PG8_STAGE(PG8_SA(1, 1), a1 + hstep, voffA);
            PG8_WAIT_L(8); PG8_BAR; PG8_WAIT_L(0); PG8_MMA(0, 0, At, B0); PG8_BAR; PG8_SCHED;
            PG8_LDB(B1, 0, 1); PG8_STAGE(PG8_SB(0, 0), b2, voffB);
            PG8_BAR; PG8_WAIT_L(0); PG8_MMA(0, 1, At, B1); PG8_BAR;
            PG8_LDA(At, 0, 1); PG8_STAGE(PG8_SA(0, 0), a2, voffA);
            PG8_BAR; PG8_WAIT_L(0); PG8_MMA(1, 0, At, B0); PG8_BAR; PG8_SCHED;
            PG8_STAGE(PG8_SB(0, 1), b2 + hstep, voffB);
            PG8_WAIT_V(6); PG8_BAR; PG8_MMA(1, 1, At, B1); PG8_BAR;
            PG8_LDB(B0, 1, 0); PG8_SCHED; PG8_LDA(At, 1, 0); PG8_STAGE(PG8_SA(0, 1), a2 + hstep, voffA);
            PG8_WAIT_L(8); PG8_BAR; PG8_WAIT_L(0); PG8_MMA(0, 0, At, B0); PG8_BAR; PG8_SCHED;
            PG8_LDB(B1, 1, 1); PG8_STAGE(PG8_SB(1, 0), b3, voffB);
            PG8_BAR; PG8_WAIT_L(0); PG8_MMA(0, 1, At, B1); PG8_BAR;
            PG8_LDA(At, 1, 1); PG8_STAGE(PG8_SA(1, 0), a3, voffA);
            PG8_BAR; PG8_WAIT_L(0); PG8_MMA(1, 0, At, B0); PG8_BAR; PG8_SCHED;
            PG8_STAGE(PG8_SB(1, 1), b3 + hstep, voffB);
            PG8_WAIT_V(6); PG8_BAR; PG8_MMA(1, 1, At, B1); PG8_BAR;
            }
        }
        if constexpr (ALIGN_EPI) { if (wr == 0) PG8_BAR; }
        if constexpr (!Epi::AFTER_DRAIN) { E(acc, cur, wr, wc, fr, fq); S.done(cur); }
        if (!has_next) break;
#pragma unroll
        for (int a = 0; a < 2; ++a)
#pragma unroll
            for (int b = 0; b < 2; ++b)
#pragma unroll
                for (int m = 0; m < 4; ++m)
#pragma unroll
                    for (int n = 0; n < 2; ++n) acc[a][b][m][n] = (f32x4){0.f, 0.f, 0.f, 0.f};
        cur = nxt; cA = nA; cB = nB; ++ui;
        if constexpr (ALIGN_EPI) { if (wr == 1) PG8_BAR; }
    }
    PG8_WAIT_V(0);
    if constexpr (!ALIGN_EPI) { if (wr == 0) PG8_BAR; }
    PG8_BAR;
    if constexpr (Epi::AFTER_DRAIN) { E.fused(acc, cur, wr, wc, fr, fq, lds, wid, lane); S.done(cur); }
#undef PG8_SA
#undef PG8_SB
#undef PG8_STAGE
#undef PG8_LDA
#undef PG8_LDB
#undef PG8_MMA
#undef PG8_WAIT_V
#undef PG8_WAIT_L
#undef PG8_BAR
#undef PG8_SCHED
}
}
#define GAS __attribute__((address_space(1)))
#define LAS __attribute__((address_space(3)))
typedef unsigned short bf16;
typedef unsigned v4u __attribute__((ext_vector_type(4)));
typedef float f32x4 __attribute__((ext_vector_type(4)));
typedef short bf16x8 __attribute__((ext_vector_type(8)));
typedef GAS unsigned gu32;
typedef GAS unsigned long long gu64;
#define RLX_AGENT __ATOMIC_RELAXED, __HIP_MEMORY_SCOPE_AGENT
#define LDS_WAIT() asm volatile("s_waitcnt lgkmcnt(0)" ::: "memory")
#define VM_WAIT() asm volatile("s_waitcnt vmcnt(0)" ::: "memory")
__device__ __forceinline__ unsigned long long rt() { return __builtin_amdgcn_s_memrealtime(); }
__device__ __forceinline__ unsigned f2bf(float f) { unsigned u = __builtin_bit_cast(unsigned, f); return (u + 0x7fffu + ((u >> 16) & 1u)) >> 16; }
__device__ __forceinline__ unsigned pk2(float lo, float hi) { return f2bf(lo) | (f2bf(hi) << 16); }
#define XB_TMO      128
#define XB_XCNT(j)  (256  + 64 * (j))
#define XB_XSUB(j)  (1280 + 64 * (j))
#define XB_XGEN(j)  (2304 + 64 * (j))
#define XB_TOP      3328
#define XB_TOPGEN   3392
#define XCD_BAR_WORDS 3456
#define XB_SPIN_CAP (1u << 18)

__device__ __forceinline__ unsigned xb_ld(unsigned* p)              { return __hip_atomic_load(p, __ATOMIC_RELAXED, __HIP_MEMORY_SCOPE_AGENT); }
__device__ __forceinline__ unsigned xb_add(unsigned* p, unsigned v) { return __hip_atomic_fetch_add(p, v, __ATOMIC_RELAXED, __HIP_MEMORY_SCOPE_AGENT); }
__device__ __forceinline__ unsigned xb_xcc_id() { return (unsigned)__builtin_amdgcn_s_getreg((3 << 11) | 20) & 0xFu; }
#define XB_SPIN(cond, bar) do { unsigned _sp = 0; while (cond) { __builtin_amdgcn_s_sleep(1); \
    if ((++_sp & 255u) == 0u) { if (xb_ld(&(bar)[XB_TMO])) break; if (_sp > XB_SPIN_CAP) { atomicAdd(&(bar)[XB_TMO], 1u); break; } } } } while (0)

struct XcdBarrier {
    unsigned* bar; unsigned x;
    volatile LAS unsigned* st;
};

__device__ __forceinline__ XcdBarrier xcd_barrier_post(unsigned* bar, volatile LAS unsigned* st) {
    XcdBarrier b; b.bar = bar; b.x = xb_xcc_id(); b.st = st;
    if (threadIdx.x == 0) (void)xb_add(&bar[XB_XCNT(b.x)], 1u);
    return b;
}
__device__ __forceinline__ void xcd_barrier_complete(unsigned* bar, unsigned x, unsigned& nloc, unsigned& nx) {
    const unsigned G = gridDim.x * gridDim.y * gridDim.z;
    unsigned sum, cnt, mine, sp = 0u;
    for (;;) {
        sum = 0u; cnt = 0u; mine = 0u;
#pragma unroll
        for (unsigned j = 0; j < 16; ++j) { const unsigned c = xb_ld(&bar[XB_XCNT(j)]); sum += c; cnt += (c > 0u) ? 1u : 0u; mine = (j == x) ? c : mine; }
        if (sum == G) break;
        __builtin_amdgcn_s_sleep(1);
        if ((++sp & 255u) == 0u) { if (xb_ld(&bar[XB_TMO])) break; if (sp > XB_SPIN_CAP) { atomicAdd(&bar[XB_TMO], 1u); break; } }
    }
    nloc = mine > 0u ? mine : 1u; nx = cnt > 0u ? cnt : 1u;
}

__device__ __forceinline__ void xcd_barrier(const XcdBarrier& b) {
    asm volatile("s_waitcnt vmcnt(0)" ::: "memory");
    __syncthreads();
    if (threadIdx.x == 0) {
        unsigned* bar = b.bar;
        __builtin_amdgcn_s_waitcnt(0);
        unsigned nloc = b.st[0], nx = b.st[1];
        if (nloc == 0u) { xcd_barrier_complete(bar, b.x, nloc, nx); b.st[0] = nloc; b.st[1] = nx; }
        const unsigned old = xb_add(&bar[XB_XSUB(b.x)], 1u);
        const unsigned gen = old / nloc;
        if (old + 1u == (gen + 1u) * nloc) {
            __builtin_amdgcn_fence(__ATOMIC_RELEASE, "agent");
            asm volatile("s_waitcnt vmcnt(0)" ::: "memory");
            const unsigned og = xb_add(&bar[XB_TOP], 1u);
            const unsigned tg = og / nx;
            if (og + 1u == (tg + 1u) * nx) xb_add(&bar[XB_TOPGEN], 1u);
            else XB_SPIN(xb_ld(&bar[XB_TOPGEN]) == tg, bar);
            __builtin_amdgcn_fence(__ATOMIC_ACQUIRE, "agent");
            xb_add(&bar[XB_XGEN(b.x)], 1u);
            asm volatile("s_waitcnt vmcnt(0)" ::: "memory");
        } else {
            XB_SPIN(xb_ld(&bar[XB_XGEN(b.x)]) == gen, bar);
            __builtin_amdgcn_fence(__ATOMIC_ACQUIRE, "agent");
            asm volatile("s_waitcnt vmcnt(0)" ::: "memory");
        }
    }
    __syncthreads();
}
constexpr int NWAVES = 8, NTHR = 512;
#ifndef MK_ONE_LAUNCH
#define MK_ONE_LAUNCH 0
#endif
constexpr int NPHASE = 15;
constexpr int D = 4096, NCTX = 8192, NLAT = 4096, NTOK = 12288, INC = 19456, FFN = 11008, MODC = 24576;
constexpr int C_RQ = 0, C_RK = 2048, C_RV = 4096, C_RG = 6144, C_AQ = 8192, C_AK = 10240, C_AV = 10752, C_GR = 11264, C_GA = 15360;
constexpr float EPS = 1e-6f;
constexpr float ATT_SCALE = 0.08838834764831845f;
constexpr size_t MiB = 1u << 20;
constexpr size_t WS_CTL = 0, CTL_ZERO_BYTES = MiB;
constexpr size_t WS_MODS = 1 * MiB, WS_MPART = 2 * MiB, WS_WIN = 18 * MiB, WS_WBR = 170 * MiB, WS_WBA = 186 * MiB, WS_WOUT = 202 * MiB, WS_WUP = 234 * MiB, WS_WDN = 406 * MiB;
constexpr size_t WS_R1 = 492 * MiB, WS_R2 = 1008 * MiB, WS_R3 = 1200 * MiB, WS_END = 1392 * MiB;
constexpr size_t O_Y = 0, O_K = 50331648, O_V = 54525952, O_SF = 58720256, O_SB = 75497472, O_END = 92274688;
constexpr int CW_BAR = 4096;
constexpr int LDS_BYTES = 147456, MISC_OFF = 131072 + 320;

struct Frame {
    LAS unsigned char* lds;
    volatile LAS unsigned* MISC;
    gu32* ctl;
    int tid, lane, wave, vcu, G;
    const float *xp, *xs, *cache_k, *cache_v, *st_f, *st_b, *c, *c_ctx, *w_mod, *b_mod, *n_mix_pre, *n_mix_post, *n_ffn_pre, *n_ffn_post;
    const float *w_in, *ld_f, *ld_b, *gn_w, *sink, *w_br, *w_ba, *w_out, *w_up, *w_dn;
    float* out;
    float *mods, *mpart;
    bf16 *Win_t, *Wbr_t, *Wba_t, *Wout_t, *Wup_t, *Wdn_t;
    bf16 *P, *H1, *RO, *AO, *T1, *T2, *MIX, *H2, *UA, *UB;
    float *OF, *OB, *MO, *X1, *FF;
};

__device__ __forceinline__ float bf2f(unsigned short b) { return __uint_as_float((unsigned)b << 16); }
__device__ __forceinline__ float bflo(unsigned w) { return __uint_as_float(w << 16); }
__device__ __forceinline__ float bfhi(unsigned w) { return __uint_as_float(w & 0xffff0000u); }
__device__ __forceinline__ float wave_sum(float v) {
#pragma unroll
    for (int o = 1; o < 64; o <<= 1) v += __shfl_xor(v, o);
    return v;
}
__device__ __forceinline__ float wave_max(float v) {
#pragma unroll
    for (int o = 1; o < 64; o <<= 1) v = fmaxf(v, __shfl_xor(v, o));
    return v;
}
__device__ __forceinline__ float silu_f(float x) { return x / (1.f + __expf(-x)); }
__device__ __forceinline__ float sigm_f(float x) { return 1.f / (1.f + __expf(-x)); }
__device__ __forceinline__ const float* xrow(const Frame& F, int r) { return r < NCTX ? F.xp + (size_t)r * D : F.xs + (size_t)(r - NCTX) * D; }
__device__ __forceinline__ int cond_of(int r) { return r < NCTX ? 0 : 1 + ((r - NCTX) >> 10); }

__device__ __forceinline__ void ph_mods_partial(Frame& F) {
    LAS float* sm = (LAS float*)(F.lds);
    for (int it = F.vcu; it < 32 * 12; it += F.G) {
        const int ks = it / 12, nb = it % 12, k0 = ks * 128, n0 = nb * 2048 + F.tid * 4;
        for (int idx = F.tid; idx < 640; idx += NTHR) { const int j = idx >> 7, kk = idx & 127; const float x = (j == 0) ? F.c_ctx[k0 + kk] : F.c[(j - 1) * D + k0 + kk]; sm[idx] = silu_f(x); }
        __syncthreads();
        f32x4 acc[5];
#pragma unroll
        for (int j = 0; j < 5; ++j) acc[j] = (f32x4){0.f, 0.f, 0.f, 0.f};
        const float* wp = F.w_mod + (size_t)k0 * MODC + n0;
#pragma unroll 8
        for (int kk = 0; kk < 128; ++kk) { const f32x4 w = *(const f32x4*)(wp + (size_t)kk * MODC);
#pragma unroll
            for (int j = 0; j < 5; ++j) acc[j] += sm[j * 128 + kk] * w; }
#pragma unroll
        for (int j = 0; j < 5; ++j) *(f32x4*)(F.mpart + (size_t)(ks * 5 + j) * MODC + n0) = acc[j];
        __syncthreads();
    }
}
__device__ __forceinline__ void p0_transpose_item(const float* W, int K, int N, bf16* WT, int row_off, LAS float* scr, int item, int lane) {
    const int nblk = N / 32, kb = item / nblk, nb = item % nblk, k0 = 64 * kb, n0 = 32 * nb;
#pragma unroll 8
    for (int i = 0; i < 32; ++i) { const int kk = 2 * i + (lane >> 5); scr[kk * 33 + (lane & 31)] = W[(size_t)(k0 + kk) * N + n0 + (lane & 31)]; }
    LDS_WAIT(); asm volatile("" ::: "memory");
    const int c = lane & 7;
#pragma unroll
    for (int j = 0; j < 4; ++j) { const int n = (lane >> 3) + 8 * j; const LAS float* s = scr + (8 * c) * 33 + n;
        v4u o; o.x = pk2(s[0 * 33], s[1 * 33]); o.y = pk2(s[2 * 33], s[3 * 33]); o.z = pk2(s[4 * 33], s[5 * 33]); o.w = pk2(s[6 * 33], s[7 * 33]);
        *(GAS v4u*)(WT + (size_t)(row_off + n0 + n) * K + k0 + 8 * c) = o; }
    LDS_WAIT(); asm volatile("" ::: "memory");
}
__device__ __forceinline__ void ph_convert(Frame& F) {
    LAS float* scr = (LAS float*)(F.lds + 8192 + F.wave * 12288);
    const int gw = F.vcu * NWAVES + F.wave, NGW = F.G * NWAVES;
    constexpr int I_IN = (D / 64) * (INC / 32), I_BR = (2048 / 64) * (D / 32), I_OUT = (D / 64) * (D / 32), I_UP = (D / 64) * (2 * FFN / 32), I_DN = (FFN / 64) * (D / 32);
    constexpr int NITEMS = I_IN + 2 * I_BR + I_OUT + I_UP + I_DN;
    for (int it = gw; it < NITEMS; it += NGW) {
        int r = it;
        if (r < I_IN) { p0_transpose_item(F.w_in, D, INC, F.Win_t, 0, scr, r, F.lane); continue; } r -= I_IN;
        if (r < I_BR) { p0_transpose_item(F.w_br, 2048, D, F.Wbr_t, 0, scr, r, F.lane); continue; } r -= I_BR;
        if (r < I_BR) { p0_transpose_item(F.w_ba, 2048, D, F.Wba_t, 0, scr, r, F.lane); continue; } r -= I_BR;
        if (r < I_OUT) { p0_transpose_item(F.w_out, D, D, F.Wout_t, 0, scr, r, F.lane); continue; } r -= I_OUT;
        if (r < I_UP) { p0_transpose_item(F.w_up, D, 2 * FFN, F.Wup_t, 0, scr, r, F.lane); continue; } r -= I_UP;
        p0_transpose_item(F.w_dn, FFN, D, F.Wdn_t, 0, scr, r, F.lane);
    }
}
__device__ __forceinline__ void ph_mods_reduce(Frame& F) {
    for (int idx = F.vcu * NTHR + F.tid; idx < 5 * MODC; idx += F.G * NTHR) {
        float s = F.b_mod[idx % MODC];
        for (int ks = 0; ks < 32; ++ks) s += F.mpart[(size_t)ks * 5 * MODC + idx];
        F.mods[idx] = s;
    }
}
__device__ __forceinline__ void ph_h1(Frame& F) {
    const int gw = F.vcu * NWAVES + F.wave, NGW = F.G * NWAVES;
    for (int r = gw; r < NTOK; r += NGW) {
        const f32x4* xr = (const f32x4*)xrow(F, r) + F.lane; f32x4 v[16]; float ss = 0.f;
#pragma unroll
        for (int j = 0; j < 16; ++j) { v[j] = xr[64 * j]; ss += (v[j].x * v[j].x + v[j].y * v[j].y) + (v[j].z * v[j].z + v[j].w * v[j].w); }
        const float rstd = rsqrtf(wave_sum(ss) * (1.f / D) + EPS);
        const float* md = F.mods + (size_t)cond_of(r) * MODC;
#pragma unroll
        for (int j = 0; j < 16; ++j) { const int col = 4 * (F.lane + 64 * j);
            const f32x4 w = *(const f32x4*)(F.n_mix_pre + col), sh = *(const f32x4*)(md + col), sc = *(const f32x4*)(md + D + col);
            const f32x4 y = (v[j] * rstd * w) * (1.f + sc) + sh;
            *(unsigned long long*)(F.H1 + (size_t)r * D + col) = (unsigned long long)pk2(y.x, y.y) | ((unsigned long long)pk2(y.z, y.w) << 32); }
    }
}
__device__ __forceinline__ void unpack8(const v4u a, float (&x)[8]) { x[0] = bflo(a.x); x[1] = bfhi(a.x); x[2] = bflo(a.y); x[3] = bfhi(a.y); x[4] = bflo(a.z); x[5] = bfhi(a.z); x[6] = bflo(a.w); x[7] = bfhi(a.w); }
__device__ __forceinline__ v4u pack8(const float (&x)[8]) { v4u o; o.x = pk2(x[0], x[1]); o.y = pk2(x[2], x[3]); o.z = pk2(x[4], x[5]); o.w = pk2(x[6], x[7]); return o; }
__device__ __forceinline__ void scale_chunk(bf16* p, float s) { float x[8]; unpack8(*(const v4u*)p, x);
#pragma unroll
    for (int e = 0; e < 8; ++e) x[e] *= s;
    *(v4u*)p = pack8(x); }
template <int Q> __device__ __forceinline__ void rope_seg(bf16* seg, int ngroups, float scale, float rowpos, float colpos, int lane) {
    constexpr int CPG = Q / 8; const int total = ngroups * CPG;
    for (int ch = lane; ch < total; ch += 64) { const int g = ch / CPG, i0 = (ch % CPG) * 8; bf16* p1 = seg + g * 2 * Q + i0; bf16* p2 = p1 + Q;
        const float pos = (g & 1) ? colpos : rowpos; float x1[8], x2[8], o1[8], o2[8]; unpack8(*(const v4u*)p1, x1); unpack8(*(const v4u*)p2, x2);
#pragma unroll
        for (int e = 0; e < 8; ++e) { const float f = __builtin_amdgcn_exp2f(-(float)(i0 + e) * (13.287712379549449f / Q)); const float ang = pos * f; const float s = __sinf(ang), c = __cosf(ang);
            o1[e] = (x1[e] * c - x2[e] * s) * scale; o2[e] = (x1[e] * s + x2[e] * c) * scale; }
        *(v4u*)p1 = pack8(o1); *(v4u*)p2 = pack8(o2); }
}
__device__ __forceinline__ void ph_post(Frame& F) {
    const int gw = F.vcu * NWAVES + F.wave, NGW = F.G * NWAVES;
    for (int r = gw; r < NTOK; r += NGW) {
        bf16* pr = F.P + (size_t)r * INC;
        if (r < NCTX) {
            float x[8]; unpack8(*(const v4u*)(pr + C_AK + 8 * F.lane), x);
            float* ko = F.out + O_K + (size_t)r * 512 + 8 * F.lane; *(f32x4*)ko = (f32x4){x[0], x[1], x[2], x[3]}; *(f32x4*)(ko + 4) = (f32x4){x[4], x[5], x[6], x[7]};
            unpack8(*(const v4u*)(pr + C_AV + 8 * F.lane), x);
            float* vo = F.out + O_V + (size_t)r * 512 + 8 * F.lane; *(f32x4*)vo = (f32x4){x[0], x[1], x[2], x[3]}; *(f32x4*)(vo + 4) = (f32x4){x[4], x[5], x[6], x[7]};
#pragma unroll
            for (int m = 0; m < 4; ++m) { const int ch = F.lane + 64 * m; scale_chunk(pr + C_RK + 8 * ch, 0.0625f); scale_chunk(pr + C_AQ + 8 * ch, ATT_SCALE); }
        } else {
            const int t = (r - NCTX) & 1023; const float rowpos = (float)(t >> 6), colpos = (float)(t & 63);
            rope_seg<64>(pr + C_RQ, 16, 1.f, rowpos, colpos, F.lane);
            rope_seg<64>(pr + C_RK, 16, 0.0625f, rowpos, colpos, F.lane);
            rope_seg<32>(pr + C_AQ, 32, ATT_SCALE, rowpos, colpos, F.lane);
            rope_seg<32>(pr + C_AK, 8, 1.f, rowpos, colpos, F.lane);
        }
    }
}
__device__ __forceinline__ void ret_item(Frame& F, int row0, int L, int h, int dir, const float* s0, float* sout, float gamma) {
    LAS float* kq = (LAS float*)(F.lds);
    LAS float* pb = (LAS float*)(F.lds + 2048);
    const int tid = F.tid, vv = tid & 255, kh = tid >> 8;
    float S[128];
#pragma unroll
    for (int i = 0; i < 128; ++i) S[i] = s0 ? s0[(size_t)(kh * 128 + i) * 256 + vv] : 0.f;
    const int kqcol = (tid < 256) ? (C_RK + h * 256 + tid) : (C_RQ + h * 256 + (tid - 256));
    float* obase = dir ? F.OB : F.OF;
    int t = dir ? L - 1 : 0;
    unsigned short kq_n = F.P[(size_t)(row0 + t) * INC + kqcol], v_n = F.P[(size_t)(row0 + t) * INC + C_RV + h * 256 + vv];
    for (int n = 0; n < L; ++n) {
        const int row = row0 + t;
        kq[tid] = bf2f(kq_n); const float v = bf2f(v_n);
        __syncthreads();
        const int tn = dir ? t - 1 : t + 1;
        if (n + 1 < L) { kq_n = F.P[(size_t)(row0 + tn) * INC + kqcol]; v_n = F.P[(size_t)(row0 + tn) * INC + C_RV + h * 256 + vv]; }
        const LAS f32x4* kb = (const LAS f32x4*)(kq + kh * 128); const LAS f32x4* qb = (const LAS f32x4*)(kq + 256 + kh * 128);
        float part = 0.f;
#pragma unroll
        for (int i = 0; i < 32; ++i) { const f32x4 k4 = kb[i], q4 = qb[i];
            S[4 * i + 0] = gamma * S[4 * i + 0] + k4.x * v; part += q4.x * S[4 * i + 0];
            S[4 * i + 1] = gamma * S[4 * i + 1] + k4.y * v; part += q4.y * S[4 * i + 1];
            S[4 * i + 2] = gamma * S[4 * i + 2] + k4.z * v; part += q4.z * S[4 * i + 2];
            S[4 * i + 3] = gamma * S[4 * i + 3] + k4.w * v; part += q4.w * S[4 * i + 3]; }
        if (kh) pb[vv] = part;
        __syncthreads();
        if (!kh) obase[(size_t)row * 2048 + h * 256 + vv] = part + pb[vv];
        t = tn;
    }
    if (sout) {
#pragma unroll
        for (int i = 0; i < 128; ++i) sout[(size_t)(kh * 128 + i) * 256 + vv] = S[i];
    }
    __syncthreads();
}
__device__ __forceinline__ void ph_retention(Frame& F) {
    const int c = F.vcu;
    if (c < 64) {
        const int b = c >> 4, h = (c >> 1) & 7, dir = c & 1;
        const float gamma = __expf(-__expf((dir ? F.ld_b : F.ld_f)[h]));
        ret_item(F, NCTX + b * 1024, 1024, h, dir, (dir ? F.st_b : F.st_f) + (size_t)(b * 8 + h) * 65536, nullptr, gamma);
    } else {
        for (int it = c - 64; it < 512; it += F.G - 64) {
            const int b = it >> 4, h = (it >> 1) & 7, dir = it & 1;
            const float gamma = __expf(-__expf((dir ? F.ld_b : F.ld_f)[h]));
            ret_item(F, b * 256, 256, h, dir, nullptr, F.out + (dir ? O_SB : O_SF) + (size_t)(b * 8 + h) * 65536, gamma);
        }
    }
}
__device__ __forceinline__ float dot_bf16_row(const bf16* kp, const LAS f32x4* q4) {
    float s = 0.f;
#pragma unroll
    for (int c = 0; c < 16; ++c) { const v4u kv = *(const v4u*)(kp + 8 * c); const f32x4 qa = q4[2 * c], qb = q4[2 * c + 1];
        s += bflo(kv.x) * qa.x + bfhi(kv.x) * qa.y + bflo(kv.y) * qa.z + bfhi(kv.y) * qa.w + bflo(kv.z) * qb.x + bfhi(kv.z) * qb.y + bflo(kv.w) * qb.z + bfhi(kv.w) * qb.w; }
    return s;
}
__device__ __forceinline__ float dot_f32_row(const float* kp, const LAS f32x4* q4) {
    float s = 0.f;
#pragma unroll
    for (int c = 0; c < 32; ++c) { const f32x4 kv = *(const f32x4*)(kp + 4 * c); const f32x4 qa = q4[c]; s += kv.x * qa.x + kv.y * qa.y + kv.z * qa.z + kv.w * qa.w; }
    return s;
}
__device__ __forceinline__ void ph_attention(Frame& F) {
    LAS float* qs = (LAS float*)(F.lds + 4096 + F.wave * 4096);
    LAS float* sc = qs + 128;
    const LAS f32x4* q4 = (const LAS f32x4*)qs;
    const int gw = F.vcu * NWAVES + F.wave, NGW = F.G * NWAVES, lane = F.lane;
    for (int it = gw; it < NTOK * 16; it += NGW) {
        const int r = it >> 4, h = it & 15, kvh = h >> 2;
        const float sink = F.sink[h];
        { const unsigned w = *(const unsigned*)(F.P + (size_t)r * INC + C_AQ + h * 128 + 2 * lane); qs[2 * lane] = bflo(w); qs[2 * lane + 1] = bfhi(w); }
        LDS_WAIT(); asm volatile("" ::: "memory");
        float m = sink, acc0 = 0.f, acc1 = 0.f, sum = 0.f;
        if (r < NCTX) {
            const int b = r >> 8; const bf16* kbase = F.P + (size_t)(b * 256) * INC + C_AK + kvh * 128; const bf16* vbase = F.P + (size_t)(b * 256) * INC + C_AV + kvh * 128;
            float s[4];
#pragma unroll
            for (int i = 0; i < 4; ++i) { s[i] = dot_bf16_row(kbase + (size_t)(lane + 64 * i) * INC, q4); m = fmaxf(m, s[i]); }
            m = wave_max(m);
#pragma unroll
            for (int i = 0; i < 4; ++i) { const float p = __expf(s[i] - m); sc[lane + 64 * i] = p; sum += p; }
            sum = wave_sum(sum) + __expf(sink - m);
            LDS_WAIT(); asm volatile("" ::: "memory");
#pragma unroll 4
            for (int j = 0; j < 256; ++j) { const float p = sc[j]; const unsigned w = *(const unsigned*)(vbase + (size_t)j * INC + 2 * lane); acc0 += p * bflo(w); acc1 += p * bfhi(w); }
        } else {
            const int rl = r - NCTX, b = rl >> 10, t = rl & 1023; const int lo = t - 128 < 0 ? 0 : t - 128, hi = t + 128 > 1023 ? 1023 : t + 128, nwin = hi - lo + 1, nkeys = nwin + 512;
            const bf16* kbase = F.P + (size_t)(NCTX + b * 1024 + lo) * INC + C_AK + kvh * 128; const bf16* vbase = F.P + (size_t)(NCTX + b * 1024 + lo) * INC + C_AV + kvh * 128;
            const float* ck = F.cache_k + ((size_t)(b * 512) * 4 + kvh) * 128; const float* cv = F.cache_v + ((size_t)(b * 512) * 4 + kvh) * 128;
            for (int j = lane; j < nkeys; j += 64) { const float s = (j < nwin) ? dot_bf16_row(kbase + (size_t)j * INC, q4) : dot_f32_row(ck + (size_t)(j - nwin) * 512, q4); sc[j] = s; m = fmaxf(m, s); }
            m = wave_max(m);
            LDS_WAIT(); asm volatile("" ::: "memory");
            for (int j = lane; j < nkeys; j += 64) { const float p = __expf(sc[j] - m); sc[j] = p; sum += p; }
            sum = wave_sum(sum) + __expf(sink - m);
            LDS_WAIT(); asm volatile("" ::: "memory");
#pragma unroll 4
            for (int j = 0; j < nwin; ++j) { const float p = sc[j]; const unsigned w = *(const unsigned*)(vbase + (size_t)j * INC + 2 * lane); acc0 += p * bflo(w); acc1 += p * bfhi(w); }
#pragma unroll 4
            for (int j = 0; j < 512; ++j) { const float p = sc[nwin + j]; const float* vp = cv + (size_t)j * 512 + 2 * lane; acc0 += p * vp[0]; acc1 += p * vp[1]; }
        }
        const float inv = 1.f / sum;
        *(unsigned*)(F.AO + (size_t)r * 2048 + h * 128 + 2 * lane) = pk2(acc0 * inv, acc1 * inv);
        LDS_WAIT(); asm volatile("" ::: "memory");
    }
}
__device__ __forceinline__ void ph_ret_combine(Frame& F) {
    const int gw = F.vcu * NWAVES + F.wave, NGW = F.G * NWAVES, lane = F.lane;
    for (int it = gw; it < NTOK * 8; it += NGW) {
        const int r = it >> 3, h = it & 7; const size_t off = (size_t)r * 2048 + h * 256 + 4 * lane;
        const f32x4 a = *(const f32x4*)(F.OF + off), b = *(const f32x4*)(F.OB + off); const f32x4 o = a + b;
        const float ss = wave_sum((o.x * o.x + o.y * o.y) + (o.z * o.z + o.w * o.w));
        const float rstd = rsqrtf(ss * (1.f / 256.f) + EPS);
        const f32x4 gw4 = *(const f32x4*)(F.gn_w + h * 256 + 4 * lane);
        const unsigned long long g2 = *(const unsigned long long*)(F.P + (size_t)r * INC + C_RG + h * 256 + 4 * lane);
        const unsigned g_lo = (unsigned)g2, g_hi = (unsigned)(g2 >> 32);
        const float y0 = silu_f(bflo(g_lo)) * (o.x * rstd * gw4.x), y1 = silu_f(bfhi(g_lo)) * (o.y * rstd * gw4.y), y2 = silu_f(bflo(g_hi)) * (o.z * rstd * gw4.z), y3 = silu_f(bfhi(g_hi)) * (o.w * rstd * gw4.w);
        *(unsigned long long*)(F.RO + off) = (unsigned long long)pk2(y0, y1) | ((unsigned long long)pk2(y2, y3) << 32);
    }
}
__device__ __forceinline__ void ph_mix(Frame& F) {
    const size_t total = (size_t)NTOK * (D / 8);
    for (size_t i = (size_t)F.vcu * NTHR + F.tid; i < total; i += (size_t)F.G * NTHR) {
        const int r = (int)(i / (D / 8)), c8 = (int)(i % (D / 8)) * 8;
        float t1[8], t2[8], gr[8], ga[8], o[8];
        unpack8(*(const v4u*)(F.T1 + (size_t)r * D + c8), t1); unpack8(*(const v4u*)(F.T2 + (size_t)r * D + c8), t2);
        unpack8(*(const v4u*)(F.P + (size_t)r * INC + C_GR + c8), gr); unpack8(*(const v4u*)(F.P + (size_t)r * INC + C_GA + c8), ga);
#pragma unroll
        for (int e = 0; e < 8; ++e) o[e] = sigm_f(gr[e]) * t1[e] + sigm_f(ga[e]) * t2[e];
        *(v4u*)(F.MIX + (size_t)r * D + c8) = pack8(o);
    }
}
__device__ __forceinline__ void ph_rowA(Frame& F) {
    const int gw = F.vcu * NWAVES + F.wave, NGW = F.G * NWAVES, lane = F.lane;
    for (int r = gw; r < NTOK; r += NGW) {
        const f32x4* mo = (const f32x4*)(F.MO + (size_t)r * D) + lane; const f32x4* xr = (const f32x4*)xrow(F, r) + lane;
        const float* md = F.mods + (size_t)cond_of(r) * MODC;
        float ss = 0.f;
#pragma unroll
        for (int j = 0; j < 16; ++j) { const f32x4 v = mo[64 * j]; ss += (v.x * v.x + v.y * v.y) + (v.z * v.z + v.w * v.w); }
        const float rstd1 = rsqrtf(wave_sum(ss) * (1.f / D) + EPS);
        f32x4 x1[16]; float ss2 = 0.f;
#pragma unroll
        for (int j = 0; j < 16; ++j) { const int col = 4 * (lane + 64 * j); const f32x4 v = mo[64 * j], x = xr[64 * j];
            const f32x4 w = *(const f32x4*)(F.n_mix_post + col), g = *(const f32x4*)(md + 2 * D + col);
            x1[j] = x + g * (v * rstd1 * w); ss2 += (x1[j].x * x1[j].x + x1[j].y * x1[j].y) + (x1[j].z * x1[j].z + x1[j].w * x1[j].w);
            *(f32x4*)(F.X1 + (size_t)r * D + col) = x1[j]; }
        const float rstd2 = rsqrtf(wave_sum(ss2) * (1.f / D) + EPS);
#pragma unroll
        for (int j = 0; j < 16; ++j) { const int col = 4 * (lane + 64 * j);
            const f32x4 w = *(const f32x4*)(F.n_ffn_pre + col), sh = *(const f32x4*)(md + 3 * D + col), sc = *(const f32x4*)(md + 4 * D + col);
            const f32x4 y = (x1[j] * rstd2 * w) * (1.f + sc) + sh;
            *(unsigned long long*)(F.H2 + (size_t)r * D + col) = (unsigned long long)pk2(y.x, y.y) | ((unsigned long long)pk2(y.z, y.w) << 32); }
    }
}
__device__ __forceinline__ void ph_swiglu(Frame& F) {
    const size_t total = (size_t)NTOK * FFN / 8;
    for (size_t i = (size_t)F.vcu * NTHR + F.tid; i < total; i += (size_t)F.G * NTHR) {
        float a[8], b[8], o[8]; unpack8(*(const v4u*)(F.UA + i * 8), a); unpack8(*(const v4u*)(F.UB + i * 8), b);
#pragma unroll
        for (int e = 0; e < 8; ++e) o[e] = silu_f(a[e]) * b[e];
        *(v4u*)(F.UA + i * 8) = pack8(o);
    }
}
__device__ __forceinline__ void ph_rowB(Frame& F) {
    const int gw = F.vcu * NWAVES + F.wave, NGW = F.G * NWAVES, lane = F.lane;
    for (int r = gw; r < NTOK; r += NGW) {
        const f32x4* ff = (const f32x4*)(F.FF + (size_t)r * D) + lane; const f32x4* x1 = (const f32x4*)(F.X1 + (size_t)r * D) + lane;
        const float* md = F.mods + (size_t)cond_of(r) * MODC;
        f32x4 v[16]; float ss = 0.f;
#pragma unroll
        for (int j = 0; j < 16; ++j) { v[j] = ff[64 * j]; ss += (v[j].x * v[j].x + v[j].y * v[j].y) + (v[j].z * v[j].z + v[j].w * v[j].w); }
        const float rstd = rsqrtf(wave_sum(ss) * (1.f / D) + EPS);
#pragma unroll
        for (int j = 0; j < 16; ++j) { const int col = 4 * (lane + 64 * j);
            const f32x4 w = *(const f32x4*)(F.n_ffn_post + col), g = *(const f32x4*)(md + 5 * D + col), x = x1[64 * j];
            *(f32x4*)(F.out + O_Y + (size_t)r * D + col) = x + g * (v[j] * rstd * w); }
    }
}

struct Args { const float* in[24]; float* out; unsigned char* ws; int ph_lo, ph_hi; };
__global__ void __launch_bounds__(NTHR, 2) mk_fwd(Args args) {
    extern __shared__ __attribute__((aligned(16))) unsigned char lds[];
    Frame F;
    F.lds = (LAS unsigned char*)lds;
    F.MISC = (volatile LAS unsigned*)(F.lds + MISC_OFF);
    F.tid = threadIdx.x; F.lane = F.tid & 63; F.wave = __builtin_amdgcn_readfirstlane(F.tid >> 6);
    F.G = gridDim.x; F.vcu = blockIdx.x;
    unsigned char* ws = args.ws;
    F.ctl = (gu32*)(ws + WS_CTL);
    F.xp = args.in[0]; F.xs = args.in[1]; F.cache_k = args.in[2]; F.cache_v = args.in[3]; F.st_f = args.in[4]; F.st_b = args.in[5]; F.c = args.in[6]; F.c_ctx = args.in[7];
    F.w_mod = args.in[8]; F.b_mod = args.in[9]; F.n_mix_pre = args.in[10]; F.n_mix_post = args.in[11]; F.n_ffn_pre = args.in[12]; F.n_ffn_post = args.in[13];
    F.w_in = args.in[14]; F.ld_f = args.in[15]; F.ld_b = args.in[16]; F.gn_w = args.in[17]; F.sink = args.in[18]; F.w_br = args.in[19]; F.w_ba = args.in[20];
    F.w_out = args.in[21]; F.w_up = args.in[22]; F.w_dn = args.in[23]; F.out = args.out;
    F.mods = (float*)(ws + WS_MODS); F.mpart = (float*)(ws + WS_MPART);
    F.Win_t = (bf16*)(ws + WS_WIN); F.Wbr_t = (bf16*)(ws + WS_WBR); F.Wba_t = (bf16*)(ws + WS_WBA); F.Wout_t = (bf16*)(ws + WS_WOUT); F.Wup_t = (bf16*)(ws + WS_WUP); F.Wdn_t = (bf16*)(ws + WS_WDN);
    F.P = (bf16*)(ws + WS_R1); F.MO = (float*)(ws + WS_R1); F.UA = (bf16*)(ws + WS_R1); F.UB = F.UA + (size_t)NTOK * FFN;
    F.H1 = (bf16*)(ws + WS_R2); F.OF = (float*)(ws + WS_R2); F.OB = F.OF + (size_t)NTOK * 2048; F.T1 = (bf16*)(ws + WS_R2); F.T2 = F.T1 + (size_t)NTOK * D; F.X1 = (float*)(ws + WS_R2);
    F.RO = (bf16*)(ws + WS_R3); F.AO = F.RO + (size_t)NTOK * 2048; F.MIX = F.RO + (size_t)NTOK * D; F.H2 = (bf16*)(ws + WS_R3); F.FF = (float*)(ws + WS_R3);
    for (int u = F.tid; u < (LDS_BYTES - 131072) / 4; u += NTHR) ((LAS unsigned*)(F.lds + 131072))[u] = 0u;
    __syncthreads();
    XcdBarrier bar; bar.bar = (unsigned*)(F.ctl + CW_BAR); bar.x = 0; bar.st = nullptr;
    if (MK_ONE_LAUNCH) bar = xcd_barrier_post((unsigned*)(F.ctl + CW_BAR), F.MISC + 8);
    const int lo = args.ph_lo, hi = args.ph_hi;
#define IN(k) (lo <= (k) && (k) < hi)
#define SEAM(k) do { if (IN(k) && IN((k) + 1)) xcd_barrier(bar); } while (0)
    if (IN(0)) { ph_mods_partial(F); ph_convert(F); } SEAM(0);
    if (IN(1)) { ph_mods_reduce(F); } SEAM(1);
    if (IN(2)) { ph_h1(F); } SEAM(2);
    if (IN(3)) { pg8::Gemm g{F.H1, F.Win_t, NTOK, INC, D}; pg8::StaticOrder S; S.init(NTOK, INC, F.G, (int)blockIdx.x);
        pg8::EpiBf16<0> E{F.P, INC, nullptr, 0, 0, 1.f};
        pg8::gemm_phase<pg8::EpiBf16<0>, pg8::StaticOrder, true, true>(F.lds, g, S, E); } SEAM(3);
    if (IN(4)) { ph_post(F); } SEAM(4);
    if (IN(5)) { ph_retention(F); ph_attention(F); } SEAM(5);
    if (IN(6)) { ph_ret_combine(F); } SEAM(6);
    if (IN(7)) {
        { pg8::Gemm g{F.RO, F.Wbr_t, NTOK, D, 2048}; pg8::StaticOrder S; S.init(NTOK, D, F.G, (int)blockIdx.x); pg8::EpiBf16<0> E{F.T1, D, nullptr, 0, 0, 1.f};
          pg8::gemm_phase<pg8::EpiBf16<0>, pg8::StaticOrder, true, true>(F.lds, g, S, E); }
        { pg8::Gemm g{F.AO, F.Wba_t, NTOK, D, 2048}; pg8::StaticOrder S; S.init(NTOK, D, F.G, (int)blockIdx.x); pg8::EpiBf16<0> E{F.T2, D, nullptr, 0, 0, 1.f};
          pg8::gemm_phase<pg8::EpiBf16<0>, pg8::StaticOrder, true, true>(F.lds, g, S, E); } } SEAM(7);
    if (IN(8)) { ph_mix(F); } SEAM(8);
    if (IN(9)) { pg8::Gemm g{F.MIX, F.Wout_t, NTOK, D, D}; pg8::StaticOrder S; S.init(NTOK, D, F.G, (int)blockIdx.x); pg8::EpiF32 E{F.MO, D};
        pg8::gemm_phase<pg8::EpiF32, pg8::StaticOrder, true, true>(F.lds, g, S, E); } SEAM(9);
    if (IN(10)) { ph_rowA(F); } SEAM(10);
    if (IN(11)) { pg8::Gemm g{F.H2, F.Wup_t, NTOK, 2 * FFN, D}; pg8::StaticOrder S; S.init(NTOK, 2 * FFN, F.G, (int)blockIdx.x);
        pg8::EpiBf16<0> E{F.UA, FFN, nullptr, FFN, (size_t)NTOK * FFN, 1.f};
        pg8::gemm_phase<pg8::EpiBf16<0>, pg8::StaticOrder, true, true>(F.lds, g, S, E); } SEAM(11);
    if (IN(12)) { ph_swiglu(F); } SEAM(12);
    if (IN(13)) { pg8::Gemm g{F.UA, F.Wdn_t, NTOK, D, FFN}; pg8::StaticOrder S; S.init(NTOK, D, F.G, (int)blockIdx.x); pg8::EpiF32 E{F.FF, D};
        pg8::gemm_phase<pg8::EpiF32, pg8::StaticOrder, true, true>(F.lds, g, S, E); } SEAM(13);
    if (IN(14)) { ph_rowB(F); }
#undef IN
#undef SEAM
}

extern "C" void kernel_launch(void* const* d_in, const int* in_sizes, int n_in, void* d_out, int out_size, void* d_ws, size_t ws_size, hipStream_t stream) {
    static int grid = 0;
    if (grid == 0) {
        if (n_in != 24 || out_size != (int)O_END || ws_size < WS_END) { fprintf(stderr, "kernel_launch: unexpected shapes (n_in %d out %d ws %zu)\n", n_in, out_size, ws_size); grid = -1; return; }
        int dev = 0, cus = 0, per_cu = 0;
        if (hipGetDevice(&dev) != hipSuccess || hipDeviceGetAttribute(&cus, hipDeviceAttributeMultiprocessorCount, dev) != hipSuccess) { grid = -1; return; }
        if (hipFuncSetAttribute((const void*)mk_fwd, hipFuncAttributeMaxDynamicSharedMemorySize, LDS_BYTES) != hipSuccess) { grid = -1; return; }
        if (hipOccupancyMaxActiveBlocksPerMultiprocessor(&per_cu, (const void*)mk_fwd, NTHR, LDS_BYTES) != hipSuccess || per_cu < 1) { fprintf(stderr, "kernel_launch: occupancy query says %d\n", per_cu); }
        (void)hipGetLastError();
        grid = cus;
        if (grid != 256) { fprintf(stderr, "kernel_launch: expected 256 CUs, got %d\n", grid); }
    }
    if (grid < 0) return;
    (void)hipMemsetAsync((char*)d_ws + WS_CTL, 0, CTL_ZERO_BYTES, stream);
    Args a{};
    for (int i = 0; i < 24; ++i) a.in[i] = (const float*)d_in[i];
    a.out = (float*)d_out; a.ws = (unsigned char*)d_ws;
#if MK_ONE_LAUNCH
    a.ph_lo = 0; a.ph_hi = NPHASE;
    hipLaunchKernelGGL(mk_fwd, dim3(grid), dim3(NTHR), LDS_BYTES, stream, a);
#else
    for (int p = 0; p < NPHASE; ++p) { a.ph_lo = p; a.ph_hi = p + 1; hipLaunchKernelGGL(mk_fwd, dim3(grid), dim3(NTHR), LDS_BYTES, stream, a); }
#endif
}
```

```cpp
#include <hip/hip_runtime.h>
#include <cstdio>
#include <cstdint>
namespace pg8 {
#define PG8_LAS __attribute__((address_space(3)))
typedef unsigned short bf16_t;
typedef short bf16x8 __attribute__((ext_vector_type(8)));
typedef float f32x4 __attribute__((ext_vector_type(4)));
typedef unsigned u32x4 __attribute__((ext_vector_type(4)));
constexpr int BM = 256, BK = 64, HALF = 128, HTB = HALF * BK * 2  , STAGE_BYTES = 8 * HTB, NXCD = 8, WGM = 8;

__host__ __device__ __forceinline__ int lds_byte(int r, int c) { const int st = (r >> 4) * 2 + (c >> 5), rr = r & 15, cc = c & 31, ob = rr * 64 + cc * 2; return st * 1024 + (ob ^ (((ob >> 9) & 1) << 5)); }
__host__ __device__ __forceinline__ void stage_rc(int b, int& R, int& C) { const int st = b / 1024, sb = b % 1024, swz = sb ^ (((sb >> 9) & 1) << 5); R = (st >> 1) * 16 + swz / 64; C = (st & 1) * 32 + (swz % 64) / 2; }
__host__ __device__ __forceinline__ int perm32(int rho) { const int n = rho >> 4, i = rho & 15; return 8 * (i >> 2) + 4 * n + (i & 3); }

struct Unit { int pm, pn; };
struct Gemm { const bf16_t* A; const bf16_t* Bt; int M, N, K; };

struct StaticOrder {
    int nM, nN, nwg, G, c;
    __host__ __device__ void init(int M, int N, int G_, int c_) { nM = M / BM; nN = N / BM; nwg = nM * nN; G = G_; c = c_; }
    __host__ __device__ bool next(int i, Unit& u) const {
        const long L = (long)i * G + c; if (L >= nwg) return false;
        int wgid = (int)L; { const int q = nwg / NXCD, r = nwg % NXCD, xcd = wgid % NXCD, off = wgid / NXCD; wgid = (xcd < r ? xcd * (q + 1) : r * (q + 1) + (xcd - r) * q) + off; }
        const int nig = WGM * nN, gid = wgid / nig, fm = gid * WGM, gsz = (nM - fm) < WGM ? (nM - fm) : WGM;
        u.pm = fm + ((wgid % nig) % gsz); u.pn = (wgid % nig) / gsz; return true;
    }
    __device__ __forceinline__ void a_ready(const Unit&) const {}
    __device__ __forceinline__ void done(const Unit&) const {}
};

__device__ __forceinline__ unsigned cvt_pk_bf16(float lo, float hi) { unsigned r; asm volatile("v_cvt_pk_bf16_f32 %0, %1, %2" : "=v"(r) : "v"(lo), "v"(hi)); return r; }
typedef float f32x2 __attribute__((ext_vector_type(2)));
__device__ __forceinline__ f32x2 gelu_pk(f32x2 v) {
    const f32x2 av = __builtin_elementwise_abs(v), d = av * 0.2316418882f + 1.0f;
    f32x2 t; t.x = __builtin_amdgcn_rcpf(d.x); t.y = __builtin_amdgcn_rcpf(d.y);
    f32x2 q = t * 0.5307027145f + (-0.7265760135f); q = q * t + 0.7107068705f; q = q * t + (-0.142248368f); q = q * t + 0.127414796f; q = q * t;
    const f32x2 s = (v * v) * (-0.72134752044f);
    f32x2 e; e.x = __builtin_amdgcn_exp2f(s.x); e.y = __builtin_amdgcn_exp2f(s.y);
    const f32x2 m = v * (q * e), r = v - m;
    f32x2 o; o.x = v.x < 0.f ? m.x : r.x; o.y = v.y < 0.f ? m.y : r.y; return o;
}

template <int ACT  > struct EpiBf16 {
    static constexpr bool PERM = true, AFTER_DRAIN = false; static_assert(ACT == 0 || ACT == 1, "EpiBf16: ACT is 0 (none) or 1 (gelu_pk)");
    bf16_t* O; int ldc; const float* bias; int split_cols; size_t split_stride; float scale0;
    __device__ __forceinline__ void operator()(const f32x4 (&acc)[2][2][4][2], const Unit& u, int wr, int wc, int fr, int fq) const {
        const int row0 = u.pm * BM + wr * 64 + fr; int colt = u.pn * BM; bf16_t* base = O;
        float sc = 1.f; if (split_cols) { const int t = colt / split_cols; base += (size_t)t * split_stride; colt -= t * split_cols; if (t == 0) sc = scale0; }
        const int col0 = colt + wc * 32 + 8 * fq, bcol0 = u.pn * BM + wc * 32 + 8 * fq;
        f32x4 bv[2][2];
#pragma unroll
        for (int bj = 0; bj < 2; ++bj)
#pragma unroll
            for (int n = 0; n < 2; ++n) bv[bj][n] = bias ? *(const f32x4*)(bias + bcol0 + bj * HALF + 4 * n) : (f32x4){0.f, 0.f, 0.f, 0.f};
#pragma unroll
        for (int ai = 0; ai < 2; ++ai)
#pragma unroll
            for (int m = 0; m < 4; ++m) { bf16_t* rowp = base + (size_t)(row0 + ai * HALF + m * 16) * ldc + col0;
#pragma unroll
                for (int bj = 0; bj < 2; ++bj) { f32x4 v0 = acc[ai][bj][m][0] + bv[bj][0], v1 = acc[ai][bj][m][1] + bv[bj][1];
                    if (ACT == 1) { f32x2 a = gelu_pk((f32x2){v0[0], v0[1]}), b = gelu_pk((f32x2){v0[2], v0[3]}), c = gelu_pk((f32x2){v1[0], v1[1]}), d = gelu_pk((f32x2){v1[2], v1[3]});
                        v0 = (f32x4){a.x, a.y, b.x, b.y}; v1 = (f32x4){c.x, c.y, d.x, d.y}; }
                    v0 = v0 * sc; v1 = v1 * sc; u32x4 w; w.x = cvt_pk_bf16(v0[0], v0[1]); w.y = cvt_pk_bf16(v0[2], v0[3]); w.z = cvt_pk_bf16(v1[0], v1[1]); w.w = cvt_pk_bf16(v1[2], v1[3]);
                    *(u32x4*)(rowp + bj * HALF) = w; } }
    }
};
struct EpiF32 {
    static constexpr bool PERM = false, AFTER_DRAIN = false;
    float* C; int ldc;
    __device__ __forceinline__ void operator()(const f32x4 (&acc)[2][2][4][2], const Unit& u, int wr, int wc, int fr, int fq) const {
        const int row0 = u.pm * BM + wr * 64 + fr, col0 = u.pn * BM + wc * 32 + 4 * fq;
#pragma unroll
        for (int ai = 0; ai < 2; ++ai)
#pragma unroll
            for (int m = 0; m < 4; ++m) { float* rowp = C + (size_t)(row0 + ai * HALF + m * 16) * ldc + col0;
#pragma unroll
                for (int bj = 0; bj < 2; ++bj)
#pragma unroll
                    for (int n = 0; n < 2; ++n) *(f32x4*)(rowp + bj * HALF + n * 16) = acc[ai][bj][m][n]; }
    }
};
template <class Epi, class Sched, bool ALIGN_EPI = false, bool SP2 = false>
__device__ __forceinline__ void gemm_phase(PG8_LAS unsigned char* lds, const Gemm g, const Sched& S, const Epi& E) {
    const int tid = threadIdx.x, wid = __builtin_amdgcn_readfirstlane(tid >> 6), lane = tid & 63, wr = wid >> 2, wc = wid & 3, fr = lane & 15, fq = lane >> 4;
    const int K = g.K, nt = K / BK;
    unsigned voffA[2], voffB[2];
#pragma unroll
    for (int i = 0; i < 2; ++i) { int R, C; stage_rc(tid * 16 + i * 8192, R, C); const int Rb = Epi::PERM ? ((R & ~31) + perm32(R & 31)) : R;
        voffA[i] = (unsigned)(R * K + C) * 2u; voffB[i] = (unsigned)(Rb * K + C) * 2u; }
    const size_t kstep = (size_t)(BK * 2);
    const size_t hstep = (size_t)HALF * K * 2;
    const size_t tstep = 2 * hstep;
    const unsigned ldsw = (unsigned)wid * 1024u;
    const int aoff = lds_byte(wr * 64 + fr, fq * 8), boff = lds_byte(wc * 32 + fr, fq * 8);
#define PG8_SA(b, h) (((b) * 2 + (h)) * HTB)
#define PG8_SB(b, h) ((4 + (b) * 2 + (h)) * HTB)
#define PG8_STAGE(bufoff, gbase, voff) do { _Pragma("unroll") for (int _i = 0; _i < 2; ++_i) \
        __builtin_amdgcn_global_load_lds((const unsigned*)((const char*)(gbase) + (voff)[_i]), (PG8_LAS unsigned*)(lds + (bufoff) + ldsw + _i * 8192), 16, 0, 0); } while (0)
#define PG8_LDA(dst, b, h) do { _Pragma("unroll") for (int m = 0; m < 4; ++m) _Pragma("unroll") for (int k = 0; k < 2; ++k) dst[m][k] = *(const PG8_LAS bf16x8*)(lds + PG8_SA(b, h) + aoff + m * 2048 + k * 1024); } while (0)
#define PG8_LDB(dst, b, h) do { _Pragma("unroll") for (int n = 0; n < 2; ++n) _Pragma("unroll") for (int k = 0; k < 2; ++k) dst[n][k] = *(const PG8_LAS bf16x8*)(lds + PG8_SB(b, h) + boff + n * 2048 + k * 1024); } while (0)
#define PG8_MMA(ai, bj, At, Bt) do { __builtin_amdgcn_s_setprio(1); _Pragma("unroll") for (int m = 0; m < 4; ++m) _Pragma("unroll") for (int n = 0; n < 2; ++n) _Pragma("unroll") for (int k = 0; k < 2; ++k) \
        acc[ai][bj][m][n] = __builtin_amdgcn_mfma_f32_16x16x32_bf16(Bt[n][k], At[m][k], acc[ai][bj][m][n], 0, 0, 0); __builtin_amdgcn_s_setprio(0); } while (0)
#define PG8_WAIT_V(n) asm volatile("s_waitcnt vmcnt(" #n ")" ::: "memory")
#define PG8_WAIT_L(n) asm volatile("s_waitcnt lgkmcnt(" #n ")" ::: "memory")
#define PG8_BAR __builtin_amdgcn_s_barrier()
#define PG8_SCHED __builtin_amdgcn_sched_barrier(0)
    Unit cur, nxt; int ui = 0;
    if (!S.next(0, cur)) return;
    f32x4 acc[2][2][4][2];
#pragma unroll
    for (int a = 0; a < 2; ++a)
#pragma unroll
        for (int b = 0; b < 2; ++b)
#pragma unroll
            for (int m = 0; m < 4; ++m)
#pragma unroll
                for (int n = 0; n < 2; ++n) acc[a][b][m][n] = (f32x4){0.f, 0.f, 0.f, 0.f};
    bf16x8 At[4][2], B0[2][2], B1[2][2];
    const char* cA = (const char*)g.A + (size_t)cur.pm * tstep; const char* cB = (const char*)g.Bt + (size_t)cur.pn * tstep;
    S.a_ready(cur);
    if constexpr (SP2) {
        PG8_STAGE(PG8_SB(0, 0), cB, voffB); PG8_STAGE(PG8_SB(0, 1), cB + hstep, voffB); PG8_STAGE(PG8_SA(0, 0), cA, voffA); PG8_STAGE(PG8_SA(0, 1), cA + hstep, voffA);
        if (wr == 1) PG8_BAR;
        PG8_WAIT_V(2); PG8_BAR;
        PG8_STAGE(PG8_SB(1, 0), cB + kstep, voffB); PG8_STAGE(PG8_SA(1, 0), cA + kstep, voffA); PG8_STAGE(PG8_SB(1, 1), cB + hstep + kstep, voffB);
        PG8_WAIT_V(6); PG8_BAR;
    } else {
        PG8_STAGE(PG8_SB(0, 0), cB, voffB); PG8_STAGE(PG8_SA(0, 0), cA, voffA); PG8_STAGE(PG8_SB(0, 1), cB + hstep, voffB); PG8_STAGE(PG8_SA(0, 1), cA + hstep, voffA);
        if (wr == 1) PG8_BAR;
        PG8_WAIT_V(4); PG8_BAR;
        PG8_STAGE(PG8_SB(1, 0), cB + kstep, voffB); PG8_STAGE(PG8_SA(1, 0), cA + kstep, voffA); PG8_STAGE(PG8_SB(1, 1), cB + hstep + kstep, voffB);
        PG8_WAIT_V(6); PG8_BAR;
    }
    for (;;) {
        const bool has_next = S.next(ui + 1, nxt);
        const char* nA = has_next ? (const char*)g.A + (size_t)nxt.pm * tstep : cA; const char* nB = has_next ? (const char*)g.Bt + (size_t)nxt.pn * tstep : cB;
        for (int t = 0; t < nt; t += 2) {
            const bool last = (t == nt - 2);
            const char* a1 = cA + (size_t)(t + 1) * kstep;
            const char* a2 = last ? nA : cA + (size_t)(t + 2) * kstep; const char* b2 = last ? nB : cB + (size_t)(t + 2) * kstep;
            const char* a3 = a2 + kstep; const char* b3 = b2 + kstep;
            if (last && has_next) S.a_ready(nxt);
            if constexpr (SP2) {
            PG8_LDB(B0, 0, 0); PG8_LDB(B1, 0, 1); PG8_SCHED; PG8_LDA(At, 0, 0); PG8_STAGE(PG8_SA(1, 1), a1 + hstep, voffA);
            PG8_WAIT_V(8); PG8_WAIT_L(0); PG8_BAR; PG8_MMA(0, 0, At, B0); PG8_MMA(0, 1, At, B1); PG8_BAR; PG8_SCHED;
            PG8_LDA(At, 0, 1); PG8_STAGE(PG8_SB(0, 0), b2, voffB); PG8_STAGE(PG8_SB(0, 1), b2 + hstep, voffB); PG8_STAGE(PG8_SA(0, 0), a2, voffA);
            PG8_WAIT_V(8); PG8_WAIT_L(0); PG8_BAR; PG8_MMA(1, 0, At, B0); PG8_MMA(1, 1, At, B1); PG8_BAR; PG8_SCHED;
            PG8_LDB(B0, 1, 0); PG8_LDB(B1, 1, 1); PG8_SCHED; PG8_LDA(At, 1, 0); PG8_STAGE(PG8_SA(0, 1), a2 + hstep, voffA);
            PG8_WAIT_V(8); PG8_WAIT_L(0); PG8_BAR; PG8_MMA(0, 0, At, B0); PG8_MMA(0, 1, At, B1); PG8_BAR; PG8_SCHED;
            PG8_LDA(At, 1, 1); PG8_STAGE(PG8_SB(1, 0), b3, voffB); PG8_STAGE(PG8_SB(1, 1), b3 + hstep, voffB); PG8_STAGE(PG8_SA(1, 0), a3, voffA);
            PG8_WAIT_V(8); PG8_WAIT_L(0); PG8_BAR; PG8_MMA(1, 0, At, B0); PG8_MMA(1, 1, At, B1); PG8_BAR; PG8_SCHED;
            } else {
            PG8_LDB(B0, 0, 0); PG8_SCHED; PG8_LDA(At, 0, 0); PG8_STAGE(PG8_SA(1, 1), a1 + hstep, voffA);
            PG8_WAIT_L(8); PG8_BAR; PG8_WAIT_L(0); PG8_MMA(0, 0, At, B0); PG8_BAR; PG8_SCHED;
            PG8_LDB(B1, 0, 1); PG8_STAGE(PG8_SB(0, 0), b2, voffB);
            PG8_BAR; PG8_WAIT_L(0); PG8_MMA(0, 1, At, B1); PG8_BAR;
            PG8_LDA(At, 0, 1); PG8_STAGE(PG8_SA(0, 0), a2, voffA);
            PG8_BAR; PG8_WAIT_L(0); PG8_MMA(1, 0, At, B0); PG8_BAR; PG8_SCHED;
            PG8_STAGE(PG8_SB(0, 1), b2 + hstep, voffB);
            PG8_WAIT_V(6); PG8_BAR; PG8_MMA(1, 1, At, B1); PG8_BAR;
            PG8_LDB(B0, 1, 0); PG8_SCHED; PG8_LDA(At, 1, 0); PG8_STAGE(PG8_SA(0, 1), a2 + hstep, voffA);
            PG8_WAIT_L(8); PG8_BAR; PG8_WAIT_L(0); PG8_MMA(0, 0, At, B0); PG8_BAR; PG8_SCHED;
            PG8_LDB(B1, 1, 1); PG8_STAGE(PG8_SB(1, 0), b3, voffB);
            PG8_BAR; PG8_WAIT_L(0); PG8_MMA(0, 1, At, B1); PG8_BAR;
            PG8_LDA(At, 1, 1); PG8_STAGE(PG8_SA(1, 0), a3, voffA);
            PG8_BAR; PG8_WAIT_L(0); PG8_MMA(1, 0, At, B0); PG8_BAR; PG8_SCHED;
            PG8_STAGE(PG8_SB(1, 1), b3 + hstep, voffB);
            PG8_WAIT_V(6); PG8_BAR; PG8_MMA(1, 1, At, B1); PG8_BAR;
            }
        }
        if constexpr (ALIGN_EPI) { if (wr == 0) PG8_BAR; }
        if constexpr (!Epi::AFTER_DRAIN) { E(acc, cur, wr, wc, fr, fq); S.done(cur); }
        if (!has_next) break;
#pragma unroll
        for (int a = 0; a < 2; ++a)
#pragma unroll
            for (int b = 0; b < 2; ++b)
#pragma unroll
                for (int m = 0; m < 4; ++m)
#pragma unroll
                    for (int n = 0; n < 2; ++n) acc[a][b][m][n] = (f32x4){0.f, 0.f, 0.f, 0.f};
        cur = nxt; cA = nA; cB = nB; ++ui;
        if constexpr (ALIGN_EPI) { if (wr == 1) PG8_BAR; }
    }
    PG8_WAIT_V(0);
    if constexpr (!ALIGN_EPI) { if (wr == 0) PG8_BAR; }
    PG8_BAR;
    if constexpr (Epi::AFTER_DRAIN) { E.fused(acc, cur, wr, wc, fr, fq, lds, wid, lane); S.done(cur); }
#undef PG8_SA
#undef PG8_SB
#undef PG8_STAGE
#undef PG8_LDA
#undef PG8_LDB
#undef PG8_MMA
#undef PG8_WAIT_V
#undef PG8_WAIT_L
#undef PG8_BAR
#undef PG8_SCHED
}
}
#define GAS __attribute__((address_space(1)))
#define LAS __attribute__((address_space(3)))
typedef unsigned short bf16;
typedef unsigned v4u __attribute__((ext_vector_type(4)));
typedef float f32x4 __attribute__((ext_vector_type(4)));
typedef short bf16x8 __attribute__((ext_vector_type(8)));
typedef GAS unsigned gu32;
typedef GAS unsigned long long gu64;
#define RLX_AGENT __ATOMIC_RELAXED, __HIP_MEMORY_SCOPE_AGENT
#define LDS_WAIT() asm volatile("s_waitcnt lgkmcnt(0)" ::: "memory")
#define VM_WAIT() asm volatile("s_waitcnt vmcnt(0)" ::: "memory")
__device__ __forceinline__ unsigned long long rt() { return __builtin_amdgcn_s_memrealtime(); }
__device__ __forceinline__ unsigned f2bf(float f) { unsigned u = __builtin_bit_cast(unsigned, f); return (u + 0x7fffu + ((u >> 16) & 1u)) >> 16; }
typedef float f32x2_t __attribute__((ext_vector_type(2))); typedef __bf16 bf16x2_t __attribute__((ext_vector_type(2)));
__device__ __forceinline__ unsigned pk2(float lo, float hi) { const f32x2_t v = {lo, hi}; const bf16x2_t b = __builtin_convertvector(v, bf16x2_t); return __builtin_bit_cast(unsigned, b); }
#define XB_TMO      128
#define XB_XCNT(j)  (256  + 64 * (j))
#define XB_XSUB(j)  (1280 + 64 * (j))
#define XB_XGEN(j)  (2304 + 64 * (j))
#define XB_TOP      3328
#define XB_TOPGEN   3392
#define XCD_BAR_WORDS 3456
#define XB_SPIN_CAP (1u << 18)

__device__ __forceinline__ unsigned xb_ld(unsigned* p)              { return __hip_atomic_load(p, __ATOMIC_RELAXED, __HIP_MEMORY_SCOPE_AGENT); }
__device__ __forceinline__ unsigned xb_add(unsigned* p, unsigned v) { return __hip_atomic_fetch_add(p, v, __ATOMIC_RELAXED, __HIP_MEMORY_SCOPE_AGENT); }
__device__ __forceinline__ unsigned xb_xcc_id() { return (unsigned)__builtin_amdgcn_s_getreg((3 << 11) | 20) & 0xFu; }
#define XB_SPIN(cond, bar) do { unsigned _sp = 0; while (cond) { __builtin_amdgcn_s_sleep(1); \
    if ((++_sp & 255u) == 0u) { if (xb_ld(&(bar)[XB_TMO])) break; if (_sp > XB_SPIN_CAP) { atomicAdd(&(bar)[XB_TMO], 1u); break; } } } } while (0)

struct XcdBarrier {
    unsigned* bar; unsigned x;
    volatile LAS unsigned* st;
};

__device__ __forceinline__ XcdBarrier xcd_barrier_post(unsigned* bar, volatile LAS unsigned* st) {
    XcdBarrier b; b.bar = bar; b.x = xb_xcc_id(); b.st = st;
    if (threadIdx.x == 0) (void)xb_add(&bar[XB_XCNT(b.x)], 1u);
    return b;
}
__device__ __forceinline__ void xcd_barrier_complete(unsigned* bar, unsigned x, unsigned& nloc, unsigned& nx) {
    const unsigned G = gridDim.x * gridDim.y * gridDim.z;
    unsigned sum, cnt, mine, sp = 0u;
    for (;;) {
        sum = 0u; cnt = 0u; mine = 0u;
#pragma unroll
        for (unsigned j = 0; j < 16; ++j) { const unsigned c = xb_ld(&bar[XB_XCNT(j)]); sum += c; cnt += (c > 0u) ? 1u : 0u; mine = (j == x) ? c : mine; }
        if (sum == G) break;
        __builtin_amdgcn_s_sleep(1);
        if ((++sp & 255u) == 0u) { if (xb_ld(&bar[XB_TMO])) break; if (sp > XB_SPIN_CAP) { atomicAdd(&bar[XB_TMO], 1u); break; } }
    }
    nloc = mine > 0u ? mine : 1u; nx = cnt > 0u ? cnt : 1u;
}

__device__ __forceinline__ void xcd_barrier(const XcdBarrier& b) {
    asm volatile("s_waitcnt vmcnt(0)" ::: "memory");
    __syncthreads();
    if (threadIdx.x == 0) {
        unsigned* bar = b.bar;
        __builtin_amdgcn_s_waitcnt(0);
        unsigned nloc = b.st[0], nx = b.st[1];
        if (nloc == 0u) { xcd_barrier_complete(bar, b.x, nloc, nx); b.st[0] = nloc; b.st[1] = nx; }
        const unsigned old = xb_add(&bar[XB_XSUB(b.x)], 1u);
        const unsigned gen = old / nloc;
        if (old + 1u == (gen + 1u) * nloc) {
            __builtin_amdgcn_fence(__ATOMIC_RELEASE, "agent");
            asm volatile("s_waitcnt vmcnt(0)" ::: "memory");
            const unsigned og = xb_add(&bar[XB_TOP], 1u);
            const unsigned tg = og / nx;
            if (og + 1u == (tg + 1u) * nx) xb_add(&bar[XB_TOPGEN], 1u);
            else XB_SPIN(xb_ld(&bar[XB_TOPGEN]) == tg, bar);
            __builtin_amdgcn_fence(__ATOMIC_ACQUIRE, "agent");
            xb_add(&bar[XB_XGEN(b.x)], 1u);
            asm volatile("s_waitcnt vmcnt(0)" ::: "memory");
        } else {
            XB_SPIN(xb_ld(&bar[XB_XGEN(b.x)]) == gen, bar);
            __builtin_amdgcn_fence(__ATOMIC_ACQUIRE, "agent");
            asm volatile("s_waitcnt vmcnt(0)" ::: "memory");
        }
    }
    __syncthreads();
}
constexpr int NWAVES = 8, NTHR = 512;
#ifndef MK_ONE_LAUNCH
#define MK_ONE_LAUNCH 1
#endif
constexpr int NPHASE = 15;
constexpr int D = 4096, NCTX = 8192, NLAT = 4096, NTOK = 12288, INC = 19456, FFN = 11008, MODC = 24576;
constexpr int C_RQ = 0, C_RK = 2048, C_RV = 4096, C_RG = 6144, C_AQ = 8192, C_AK = 10240, C_AV = 10752, C_GR = 11264, C_GA = 15360;
constexpr float EPS = 1e-6f;
constexpr float LOG2E = 1.4426950408889634f;
constexpr float ATT_SCALE = 0.08838834764831845f * LOG2E;
constexpr size_t MiB = 1u << 20;
constexpr size_t WS_CTL = 0, CTL_ZERO_BYTES = MiB;
constexpr size_t WS_MODS = 512 * 1024  , WS_MPART = 2 * MiB, WS_WIN = 18 * MiB, WS_WBR = 170 * MiB, WS_WBA = 186 * MiB, WS_WOUT = 202 * MiB, WS_WUP = 234 * MiB, WS_WDN = 406 * MiB;
constexpr size_t WS_R1 = 492 * MiB, WS_R2 = 1008 * MiB, WS_R3 = 1200 * MiB, WS_END = 1392 * MiB;
constexpr size_t O_Y = 0, O_K = 50331648, O_V = 54525952, O_SF = 58720256, O_SB = 75497472, O_END = 92274688;
constexpr int CW_BAR = 4096;
constexpr int LDS_BYTES = 147456, LDSCTL_OFF = LDS_BYTES - 1024, MISC_OFF = LDSCTL_OFF + 320;

struct Frame {
    LAS unsigned char* lds;
    volatile LAS unsigned* MISC;
    gu32* ctl;
    int tid, lane, wave, vcu, G, flags;
    const float *xp, *xs, *cache_k, *cache_v, *st_f, *st_b, *c, *c_ctx, *w_mod, *b_mod, *n_mix_pre, *n_mix_post, *n_ffn_pre, *n_ffn_post;
    const float *w_in, *ld_f, *ld_b, *gn_w, *sink, *w_br, *w_ba, *w_out, *w_up, *w_dn;
    float* out;
    float *mods, *mpart;
    bf16 *Win_t, *Wbr_t, *Wba_t, *Wout_t, *Wup_t, *Wdn_t;
    bf16 *P, *H1, *RO, *AO, *T1, *T2, *MIX, *H2, *UA, *UB;
    float *OF, *OB; bf16 *MO, *X1, *FF;
    bf16 *VT, *CK, *CVT, *VTRC, *VTRL, *KT, *S0TF, *S0TB;
};

__device__ __forceinline__ float bf2f(unsigned short b) { return __uint_as_float((unsigned)b << 16); }
__device__ __forceinline__ float bflo(unsigned w) { return __uint_as_float(w << 16); }
__device__ __forceinline__ float bfhi(unsigned w) { return __uint_as_float(w & 0xffff0000u); }
__device__ __forceinline__ float wave_sum(float v) {
#pragma unroll
    for (int o = 1; o < 64; o <<= 1) v += __shfl_xor(v, o);
    return v;
}
__device__ __forceinline__ float wave_max(float v) {
#pragma unroll
    for (int o = 1; o < 64; o <<= 1) v = fmaxf(v, __shfl_xor(v, o));
    return v;
}
__device__ __forceinline__ float sigm_f(float x) { return __builtin_amdgcn_rcpf(1.f + __builtin_amdgcn_exp2f(-1.4426950408889634f * x)); }
__device__ __forceinline__ float silu_f(float x) { return x * sigm_f(x); }
__device__ __forceinline__ const float* xrow(const Frame& F, int r) { return r < NCTX ? F.xp + (size_t)r * D : F.xs + (size_t)(r - NCTX) * D; }
__device__ __forceinline__ int cond_of(int r) { return r < NCTX ? 0 : 1 + ((r - NCTX) >> 10); }

__device__ __forceinline__ void unpack8(const v4u a, float (&x)[8]) { x[0] = bflo(a.x); x[1] = bfhi(a.x); x[2] = bflo(a.y); x[3] = bfhi(a.y); x[4] = bflo(a.z); x[5] = bfhi(a.z); x[6] = bflo(a.w); x[7] = bfhi(a.w); }
__device__ __forceinline__ v4u pack8(const float (&x)[8]) { v4u o; o.x = pk2(x[0], x[1]); o.y = pk2(x[2], x[3]); o.z = pk2(x[4], x[5]); o.w = pk2(x[6], x[7]); return o; }
__device__ __forceinline__ void ph_mods_partial(Frame& F, int nb_lo, int nb_hi, int cidx, int ncu) {
    LAS float* sm = (LAS float*)(F.lds);
    const int nnb = nb_hi - nb_lo;
    for (int it = cidx; it < 64 * nnb; it += ncu) {
        const int ks = it / nnb, nb = nb_lo + it % nnb, k0 = ks * 64, n0 = nb * 2048 + F.tid * 4;
        if (F.tid < 320) { const int j = F.tid >> 6, kk = F.tid & 63; const float x = (j == 0) ? F.c_ctx[k0 + kk] : F.c[(j - 1) * D + k0 + kk]; sm[F.tid] = silu_f(x); }
        __syncthreads();
        f32x4 acc[5];
#pragma unroll
        for (int j = 0; j < 5; ++j) acc[j] = (ks == 0) ? *(const f32x4*)(F.b_mod + n0) : (f32x4){0.f, 0.f, 0.f, 0.f};
        const float* wp = F.w_mod + (size_t)k0 * MODC + n0;
#pragma unroll 1
        for (int k8 = 0; k8 < 64; k8 += 8) { f32x4 wv[8];
#pragma unroll
            for (int q = 0; q < 8; ++q) wv[q] = __builtin_nontemporal_load((const f32x4*)(wp + (size_t)(k8 + q) * MODC));
            __builtin_amdgcn_sched_barrier(0);
#pragma unroll
            for (int q = 0; q < 8; ++q)
#pragma unroll
                for (int j = 0; j < 5; ++j) acc[j] += sm[j * 64 + k8 + q] * wv[q]; }
        if (!(F.flags & 1))
#pragma unroll
        for (int j = 0; j < 5; ++j) { float* mp = F.mods + (size_t)j * MODC + n0;
            __hip_atomic_fetch_add(mp + 0, acc[j].x, __ATOMIC_RELAXED, __HIP_MEMORY_SCOPE_AGENT); __hip_atomic_fetch_add(mp + 1, acc[j].y, __ATOMIC_RELAXED, __HIP_MEMORY_SCOPE_AGENT);
            __hip_atomic_fetch_add(mp + 2, acc[j].z, __ATOMIC_RELAXED, __HIP_MEMORY_SCOPE_AGENT); __hip_atomic_fetch_add(mp + 3, acc[j].w, __ATOMIC_RELAXED, __HIP_MEMORY_SCOPE_AGENT); }
        __syncthreads();
    }
}
template <bool UPPERM> __device__ __forceinline__ void p0_transpose_item(const float* W, int K, int N, bf16* WT, int row_off, LAS float* scr, int item, int lane) {
    const int nblk = N / 32, kb = item / nblk, nb = item % nblk, k0 = 64 * kb, n0 = 32 * nb;
    const int d0 = UPPERM ? (n0 < FFN ? 256 * (n0 / 128) + (n0 % 128) : 256 * ((n0 - FFN) / 128) + 128 + ((n0 - FFN) % 128)) : n0;
#pragma unroll 8
    for (int i = 0; i < 32; ++i) { const int kk = 2 * i + (lane >> 5); scr[kk * 33 + (lane & 31)] = __builtin_nontemporal_load(W + (size_t)(k0 + kk) * N + n0 + (lane & 31)); }
    LDS_WAIT(); asm volatile("" ::: "memory");
    const int c = lane & 7;
#pragma unroll
    for (int j = 0; j < 4; ++j) { const int n = (lane >> 3) + 8 * j; const LAS float* s = scr + (8 * c) * 33 + n;
        v4u o; o.x = pk2(s[0 * 33], s[1 * 33]); o.y = pk2(s[2 * 33], s[3 * 33]); o.z = pk2(s[4 * 33], s[5 * 33]); o.w = pk2(s[6 * 33], s[7 * 33]);
        *(GAS v4u*)(WT + (size_t)(row_off + d0 + n) * K + k0 + 8 * c) = o; }
    LDS_WAIT(); asm volatile("" ::: "memory");
}
template <bool UPPERM> __device__ __forceinline__ void p0_item4(const float* W, int K, int N, bf16* WT, LAS float* scr, int item, int lane) {
    const int nblk = N / 32, kg = item / nblk, nb = item - kg * nblk;
#pragma unroll 1
    for (int s = 0; s < 4; ++s) p0_transpose_item<UPPERM>(W, K, N, WT, 0, scr, (4 * kg + s) * nblk + nb, lane);
}
__device__ __forceinline__ void ph_convert(Frame& F, int part, int cidx, int ncu) {
    LAS float* scr = (LAS float*)(F.lds + 8192 + F.wave * 12288);
    const int gw = cidx * NWAVES + F.wave, NGW = ncu * NWAVES;
    constexpr int I_IN = (D / 256) * (INC / 32), I_BR = (2048 / 256) * (D / 32), I_OUT = (D / 256) * (D / 32), I_UP = (D / 256) * (2 * FFN / 32), I_DN = (FFN / 256) * (D / 32);
    if (part == 0) {
        for (int it = gw; it < I_IN + I_UP; it += NGW) {
            if (it < I_IN) p0_item4<false>(F.w_in, D, INC, F.Win_t, scr, it, F.lane);
            else p0_item4<true>(F.w_up, D, 2 * FFN, F.Wup_t, scr, it - I_IN, F.lane); }
    } else if (part == 1) {
        for (int it = gw; it < 2 * I_BR + I_OUT; it += NGW) {
            if (it < I_BR) p0_item4<false>(F.w_br, 2048, D, F.Wbr_t, scr, it, F.lane);
            else if (it < 2 * I_BR) p0_item4<false>(F.w_ba, 2048, D, F.Wba_t, scr, it - I_BR, F.lane);
            else p0_item4<false>(F.w_out, D, D, F.Wout_t, scr, it - 2 * I_BR, F.lane); }
    } else {
        for (int it = gw; it < I_DN; it += NGW) p0_item4<false>(F.w_dn, FFN, D, F.Wdn_t, scr, it, F.lane);
    }
}
__device__ __forceinline__ void ph_cache(Frame& F) {
    for (int idx = F.vcu * NTHR + F.tid; idx < 131072; idx += F.G * NTHR) {
        { const int d8 = idx & 15, j = (idx >> 4) & 511, kvh = (idx >> 13) & 3, b = idx >> 15;
          const float* sp = F.cache_k + ((size_t)(b * 512 + j) * 4 + kvh) * 128 + d8 * 8; const f32x4 a = *(const f32x4*)sp, c2 = *(const f32x4*)(sp + 4);
          v4u o; o.x = pk2(a.x, a.y); o.y = pk2(a.z, a.w); o.z = pk2(c2.x, c2.y); o.w = pk2(c2.z, c2.w);
          *(v4u*)(F.CK + ((size_t)(b * 4 + kvh) * 512 + j) * 128 + d8 * 8) = o; }
        { const int jj8 = idx & 7, d = (idx >> 3) & 127, jb = (idx >> 10) & 7, kvh = (idx >> 13) & 3, b = idx >> 15;
          float x[8];
#pragma unroll
          for (int e = 0; e < 8; ++e) x[e] = F.cache_v[((size_t)(b * 512 + jb * 64 + jj8 * 8 + e) * 4 + kvh) * 128 + d];
          *(v4u*)(F.CVT + (((size_t)(b * 4 + kvh) * 8 + jb) * 128 + d) * 64 + jj8 * 8) = pack8(x); }
    }
}
__device__ __forceinline__ void ph_s0t(Frame& F) {
    for (int idx = F.vcu * NTHR + F.tid; idx < 2 * 32 * 256 * 32; idx += F.G * NTHR) {
        const int k8 = idx & 31, dv = (idx >> 5) & 255, bh = (idx >> 13) & 31, dir = idx >> 18;
        const float* sp = (dir ? F.st_b : F.st_f) + ((size_t)bh * 256 + 8 * k8) * 256 + dv; float x[8];
#pragma unroll
        for (int e = 0; e < 8; ++e) x[e] = sp[(size_t)e * 256];
        *(v4u*)((dir ? F.S0TB : F.S0TF) + ((size_t)bh * 256 + dv) * 256 + 8 * k8) = pack8(x);
    }
}
__device__ __forceinline__ void ph_h1(Frame& F) {
    const int gw = F.vcu * NWAVES + F.wave, NGW = F.G * NWAVES;
    for (int r = gw; r < NTOK; r += NGW) {
        const f32x4* xr = (const f32x4*)xrow(F, r) + F.lane; f32x4 v[16]; float ss = 0.f;
#pragma unroll
        for (int j = 0; j < 16; ++j) v[j] = __builtin_nontemporal_load(xr + 64 * j);
#pragma unroll
        for (int j = 0; j < 16; ++j) ss += (v[j].x * v[j].x + v[j].y * v[j].y) + (v[j].z * v[j].z + v[j].w * v[j].w);
        const float rstd = rsqrtf(wave_sum(ss) * (1.f / D) + EPS);
        const float* md = F.mods + (size_t)cond_of(r) * MODC;
#pragma unroll
        for (int jb = 0; jb < 16; jb += 4) { f32x4 w[4], sh[4], sc[4];
#pragma unroll
            for (int q = 0; q < 4; ++q) { const int col = 4 * (F.lane + 64 * (jb + q)); w[q] = *(const f32x4*)(F.n_mix_pre + col); sh[q] = *(const f32x4*)(md + col); sc[q] = *(const f32x4*)(md + D + col); }
            __builtin_amdgcn_sched_barrier(0);
#pragma unroll
            for (int q = 0; q < 4; ++q) { const int col = 4 * (F.lane + 64 * (jb + q)); const f32x4 y = (v[jb + q] * rstd * w[q]) * (1.f + sc[q]) + sh[q];
                *(unsigned long long*)(F.H1 + (size_t)r * D + col) = (unsigned long long)pk2(y.x, y.y) | ((unsigned long long)pk2(y.z, y.w) << 32); }
            __builtin_amdgcn_sched_barrier(0); }
    }
}
__device__ __forceinline__ void scale_chunk(bf16* p, float s) { float x[8]; unpack8(*(const v4u*)p, x);
#pragma unroll
    for (int e = 0; e < 8; ++e) x[e] *= s;
    *(v4u*)p = pack8(x); }
template <int Q> __device__ __forceinline__ void rope_ld(const bf16* seg, int ch, v4u& a, v4u& b) { constexpr int CPG = Q / 8; const int g = ch / CPG, i0 = (ch % CPG) * 8; const bf16* p1 = seg + g * 2 * Q + i0; a = *(const v4u*)p1; b = *(const v4u*)(p1 + Q); }
template <int Q> __device__ __forceinline__ void rope_st(bf16* seg, int ch, const v4u a, const v4u b, float scale, float rowpos, float colpos) {
    constexpr int CPG = Q / 8; const int g = ch / CPG, i0 = (ch % CPG) * 8; bf16* p1 = seg + g * 2 * Q + i0; bf16* p2 = p1 + Q;
    const float pos = (g & 1) ? colpos : rowpos; float x1[8], x2[8], o1[8], o2[8]; unpack8(a, x1); unpack8(b, x2);
#pragma unroll
    for (int e = 0; e < 8; ++e) { const float f = __builtin_amdgcn_exp2f(-(float)(i0 + e) * (13.287712379549449f / Q)); const float ang = pos * f; const float s = __sinf(ang), c = __cosf(ang);
        o1[e] = (x1[e] * c - x2[e] * s) * scale; o2[e] = (x1[e] * s + x2[e] * c) * scale; }
    *(v4u*)p1 = pack8(o1); *(v4u*)p2 = pack8(o2);
}
__device__ __forceinline__ void ph_post(Frame& F) {
    const int gw = F.vcu * NWAVES + F.wave, NGW = F.G * NWAVES, lane = F.lane;
    for (int r = gw; r < NTOK; r += NGW) {
        bf16* pr = F.P + (size_t)r * INC;
        if (r < NCTX) {
            const v4u kv = *(const v4u*)(pr + C_AK + 8 * lane), vv = *(const v4u*)(pr + C_AV + 8 * lane);
            __builtin_amdgcn_sched_barrier(0);
            float x[8]; unpack8(kv, x);
            float* ko = F.out + O_K + (size_t)r * 512 + 8 * lane; *(f32x4*)ko = (f32x4){x[0], x[1], x[2], x[3]}; *(f32x4*)(ko + 4) = (f32x4){x[4], x[5], x[6], x[7]};
            unpack8(vv, x);
            float* vo = F.out + O_V + (size_t)r * 512 + 8 * lane; *(f32x4*)vo = (f32x4){x[0], x[1], x[2], x[3]}; *(f32x4*)(vo + 4) = (f32x4){x[4], x[5], x[6], x[7]};
        } else {
            const int t = (r - NCTX) & 1023; const float rowpos = (float)(t >> 6), colpos = (float)(t & 63);
            v4u a[7], b[7];
            rope_ld<64>(pr + C_RQ, lane, a[0], b[0]); rope_ld<64>(pr + C_RQ, lane + 64, a[1], b[1]);
            rope_ld<64>(pr + C_RK, lane, a[2], b[2]); rope_ld<64>(pr + C_RK, lane + 64, a[3], b[3]);
            rope_ld<32>(pr + C_AQ, lane, a[4], b[4]); rope_ld<32>(pr + C_AQ, lane + 64, a[5], b[5]);
            rope_ld<32>(pr + C_AK, lane & 31, a[6], b[6]);
            __builtin_amdgcn_sched_barrier(0);
            rope_st<64>(pr + C_RQ, lane, a[0], b[0], 1.f, rowpos, colpos); rope_st<64>(pr + C_RQ, lane + 64, a[1], b[1], 1.f, rowpos, colpos);
            rope_st<64>(pr + C_RK, lane, a[2], b[2], 1.f, rowpos, colpos); rope_st<64>(pr + C_RK, lane + 64, a[3], b[3], 1.f, rowpos, colpos);
            rope_st<32>(pr + C_AQ, lane, a[4], b[4], ATT_SCALE, rowpos, colpos); rope_st<32>(pr + C_AQ, lane + 64, a[5], b[5], ATT_SCALE, rowpos, colpos);
            if (lane < 32) rope_st<32>(pr + C_AK, lane, a[6], b[6], 1.f, rowpos, colpos);
        }
    }
}
template <bool SCALE> __device__ __forceinline__ void tr_tile(const bf16* srow, bf16* dst, size_t dstride, float scale, LAS unsigned char* scr, int lane) {
    v4u a[8];
#pragma unroll
    for (int c8 = 0; c8 < 8; ++c8) a[c8] = *(const v4u*)(srow + 8 * c8);
    __builtin_amdgcn_sched_barrier(0);
#pragma unroll
    for (int c8 = 0; c8 < 8; ++c8) { LAS unsigned short* d = (LAS unsigned short*)(scr + (8 * c8) * 144 + 2 * lane); unsigned w[4] = {a[c8].x, a[c8].y, a[c8].z, a[c8].w};
#pragma unroll
        for (int q = 0; q < 4; ++q) { unsigned lo = w[q] & 0xffffu, hi = w[q] >> 16;
            if (SCALE) { const unsigned p = pk2(bflo(w[q]) * scale, bfhi(w[q]) * scale); lo = p & 0xffffu; hi = p >> 16; }
            d[(2 * q) * 72] = (unsigned short)lo; d[(2 * q + 1) * 72] = (unsigned short)hi; } }
    LDS_WAIT(); asm volatile("" ::: "memory");
#pragma unroll
    for (int j = 0; j < 8; ++j) { const int f = (lane >> 3) + 8 * j; const v4u o = *(const LAS v4u*)(scr + f * 144 + 16 * (lane & 7)); *(v4u*)(dst + (size_t)f * dstride + 8 * (lane & 7)) = o; }
    LDS_WAIT(); asm volatile("" ::: "memory");
}
__device__ __forceinline__ void ph_transposes(Frame& F) {
    LAS unsigned char* scr = F.lds + F.wave * 9216;
    const int gw = F.vcu * NWAVES + F.wave, NGW = F.G * NWAVES, lane = F.lane;
    for (int it = gw; it < 15872; it += NGW) {
        if (it < 1536) { const int blk = it >> 3, kvh = (it >> 1) & 3, half = it & 1;
            tr_tile<false>(F.P + (size_t)(blk * 64 + lane) * INC + C_AV + kvh * 128 + 64 * half, F.VT + (size_t)(blk * 4 + kvh) * 8192 + (size_t)(64 * half) * 64, 64, 1.f, scr, lane);
        } else if (it < 7680) { const int i2 = it - 1536, blk = i2 >> 5, h = (i2 >> 2) & 7, q = i2 & 3, row0 = blk * 64;
            const bf16* srow = F.P + (size_t)(row0 + lane) * INC + C_RV + h * 256 + 64 * q;
            if (row0 < NCTX) { const int b = row0 >> 8, t0 = row0 & 255; tr_tile<false>(srow, F.VTRC + ((size_t)(b * 8 + h) * 256 + 64 * q) * 256 + t0, 256, 1.f, scr, lane); }
            else { const int rl = row0 - NCTX, b = rl >> 10, t0 = rl & 1023; tr_tile<false>(srow, F.VTRL + ((size_t)(b * 8 + h) * 256 + 64 * q) * 1024 + t0, 1024, 1.f, scr, lane); }
        } else { const int i2 = it - 7680, blk = i2 >> 6, h = (i2 >> 3) & 7, q = (i2 >> 1) & 3, dir = i2 & 1, row0 = blk * 64, b = row0 >> 8, t0 = row0 & 255, t = t0 + lane;
            const float lg2 = -__expf((dir ? F.ld_b : F.ld_f)[h]) * LOG2E;
            const float sc = __builtin_amdgcn_exp2f((float)(dir ? t : 255 - t) * lg2) * 0.0625f;
            tr_tile<true>(F.P + (size_t)(row0 + lane) * INC + C_RK + h * 256 + 64 * q, F.KT + ((size_t)((b * 8 + h) * 2 + dir) * 256 + 64 * q) * 256 + t0, 256, sc, scr, lane);
        }
    }
}
#define WG_BAR() do { asm volatile("s_waitcnt lgkmcnt(0)" ::: "memory"); __builtin_amdgcn_s_barrier(); asm volatile("" ::: "memory"); } while (0)
typedef float f32x16 __attribute__((ext_vector_type(16)));
constexpr int AT_KROW = 272, AT_VROW = 136, AT_KBYTES = 64 * AT_KROW, AT_BUF = AT_KBYTES + 128 * AT_VROW;
struct AtTile { const bf16* k; int kstride; const bf16* vt; int kpos0; bool masked; };
__device__ __forceinline__ void at_gload(const AtTile& T, int tid, v4u (&kr)[2], v4u (&vr)[2]) {
    const unsigned ko = (unsigned)(tid >> 4) * (unsigned)T.kstride * 2u + (unsigned)(tid & 15) * 16u, ks = 32u * (unsigned)T.kstride * 2u, vo = (unsigned)tid * 16u;
    const char* kp = (const char*)T.k; const char* vp = (const char*)T.vt;
#pragma unroll
    for (int i = 0; i < 2; ++i) { kr[i] = *(const v4u*)(kp + (ko + i * ks)); vr[i] = *(const v4u*)(vp + (vo + i * 8192u)); }
}
__device__ __forceinline__ void at_lstore(LAS unsigned char* buf, int tid, const v4u (&kr)[2], const v4u (&vr)[2]) {
    LAS unsigned char* kd = buf + (tid >> 4) * AT_KROW + (tid & 15) * 16; LAS unsigned char* vd = buf + AT_KBYTES + (tid >> 3) * AT_VROW + (tid & 7) * 16;
#pragma unroll
    for (int i = 0; i < 2; ++i) {
        *(LAS v4u*)(kd + i * 32 * AT_KROW) = kr[i];
        LAS unsigned long long* vp = (LAS unsigned long long*)(vd + i * 64 * AT_VROW);
        vp[0] = (unsigned long long)vr[i].x | ((unsigned long long)vr[i].y << 32); vp[1] = (unsigned long long)vr[i].z | ((unsigned long long)vr[i].w << 32); }
}
__device__ __forceinline__ AtTile at_tile(const Frame& F, int kind, int b, int kvh, int t0, int nwin, int i0, int i) {
    AtTile T;
    if (kind == 0) { const int row = b * 256 + 64 * i; T.k = F.P + (size_t)row * INC + C_AK + kvh * 128; T.kstride = INC; T.vt = F.VT + ((size_t)(row >> 6) * 4 + kvh) * 8192; T.kpos0 = 0; T.masked = false; }
    else if (i < nwin) { const int ks = t0 - 128 + 64 * (i0 + i); const int row = NCTX + b * 1024 + ks; T.k = F.P + (size_t)row * INC + C_AK + kvh * 128; T.kstride = INC; T.vt = F.VT + ((size_t)(row >> 6) * 4 + kvh) * 8192; T.kpos0 = ks; T.masked = true; }
    else { const int j = i - nwin; T.k = F.CK + ((size_t)(b * 4 + kvh) * 512 + 64 * j) * 128; T.kstride = 128; T.vt = F.CVT + ((size_t)(b * 4 + kvh) * 8 + j) * 8192; T.kpos0 = 0; T.masked = false; }
    return T;
}
__device__ __forceinline__ void at_unit(Frame& F, int kind, int b, int kvh, int tb) {
    const int tid = F.tid, lane = F.lane, r = lane & 31, hi = lane >> 5, g = F.wave & 3, sub = F.wave >> 2, h = kvh * 4 + g;
    const int t0 = tb * 64;
    int nt, nwin = 0, i0 = 0;
    if (kind == 0) nt = 4; else { i0 = t0 >= 128 ? 0 : (128 - t0) / 64; const int il = (1088 - t0) / 64 > 4 ? 4 : (1088 - t0) / 64; nwin = il - i0 + 1; nt = nwin + 8; }
    const int rowbase = (kind == 0 ? b * 256 : NCTX + b * 1024) + t0 + 32 * sub;
    const int tq = t0 + 32 * sub + r;
    bf16x8 qf[8];
    { const bf16* qp = F.P + (size_t)(rowbase + r) * INC + C_AQ + h * 128 + 8 * hi;
#pragma unroll
      for (int ds = 0; ds < 8; ++ds) qf[ds] = *(const bf16x8*)(qp + 16 * ds); }
    __builtin_amdgcn_sched_barrier(0);
    if (kind == 0) {
#pragma unroll
        for (int ds = 0; ds < 8; ++ds) { const v4u w = __builtin_bit_cast(v4u, qf[ds]); v4u o;
            o.x = pk2(bflo(w.x) * ATT_SCALE, bfhi(w.x) * ATT_SCALE); o.y = pk2(bflo(w.y) * ATT_SCALE, bfhi(w.y) * ATT_SCALE); o.z = pk2(bflo(w.z) * ATT_SCALE, bfhi(w.z) * ATT_SCALE); o.w = pk2(bflo(w.w) * ATT_SCALE, bfhi(w.w) * ATT_SCALE);
            qf[ds] = __builtin_bit_cast(bf16x8, o); }
    }
    float m = F.sink[h] * LOG2E, l = hi ? 0.f : 1.f;
    f32x16 o[4];
#pragma unroll
    for (int db = 0; db < 4; ++db)
#pragma unroll
        for (int e = 0; e < 16; ++e) o[db][e] = 0.f;
    v4u kr[2], vr[2];
    { const AtTile T = at_tile(F, kind, b, kvh, t0, nwin, i0, 0); at_gload(T, tid, kr, vr); at_lstore(F.lds, tid, kr, vr); }
    __syncthreads();
    unsigned touch_prev = 0u;
#pragma unroll 1
    for (int i = 0; i < nt; ++i) {
        asm volatile("" :: "v"(touch_prev));
        LAS unsigned char* buf = F.lds + (i & 1) * AT_BUF;
        const AtTile T = at_tile(F, kind, b, kvh, t0, nwin, i0, i);
        if (i + 1 < nt) { const AtTile Tn = at_tile(F, kind, b, kvh, t0, nwin, i0, i + 1); at_gload(Tn, tid, kr, vr); }
        const AtTile T2 = at_tile(F, kind, b, kvh, t0, nwin, i0, (i + 2 < nt) ? i + 2 : nt - 1);
        const unsigned touch = *(const unsigned*)(T2.k + (size_t)((tid >> 1) & 63) * T2.kstride + (tid & 1) * 64);
        f32x16 s[2];
#pragma unroll
        for (int kb = 0; kb < 2; ++kb) {
#pragma unroll
            for (int e = 0; e < 16; ++e) s[kb][e] = 0.f;
#pragma unroll
            for (int ds = 0; ds < 8; ++ds) { const bf16x8 a = *(const LAS bf16x8*)(buf + (32 * kb + r) * AT_KROW + 32 * ds + 16 * hi); s[kb] = __builtin_amdgcn_mfma_f32_32x32x16_bf16(a, qf[ds], s[kb], 0, 0, 0); }
        }
        if (T.masked) {
#pragma unroll
            for (int kb = 0; kb < 2; ++kb)
#pragma unroll
                for (int e = 0; e < 16; ++e) { const int kpos = T.kpos0 + 32 * kb + (e & 3) + 8 * (e >> 2) + 4 * hi; const int dlt = kpos - tq; if (dlt > 128 || dlt < -128) s[kb][e] = -1e30f; }
        }
        float tmax = s[0][0];
#pragma unroll
        for (int kb = 0; kb < 2; ++kb)
#pragma unroll
            for (int e = 0; e < 16; ++e) tmax = fmaxf(tmax, s[kb][e]);
        tmax = fmaxf(tmax, __shfl_xor(tmax, 32));
        const float mn = fmaxf(m, tmax), alpha = __builtin_amdgcn_exp2f(m - mn); m = mn;
        float ls = 0.f;
#pragma unroll
        for (int kb = 0; kb < 2; ++kb)
#pragma unroll
            for (int e = 0; e < 16; ++e) { const float p = __builtin_amdgcn_exp2f(s[kb][e] - mn); s[kb][e] = p; ls += p; }
        l = l * alpha + ls;
#pragma unroll
        for (int db = 0; db < 4; ++db)
#pragma unroll
            for (int e = 0; e < 16; ++e) o[db][e] *= alpha;
        bf16x8 pf[2][2];
#pragma unroll
        for (int kb = 0; kb < 2; ++kb)
#pragma unroll
            for (int sp = 0; sp < 2; ++sp) { v4u w; w.x = pk2(s[kb][8 * sp + 0], s[kb][8 * sp + 1]); w.y = pk2(s[kb][8 * sp + 2], s[kb][8 * sp + 3]); w.z = pk2(s[kb][8 * sp + 4], s[kb][8 * sp + 5]); w.w = pk2(s[kb][8 * sp + 6], s[kb][8 * sp + 7]); pf[kb][sp] = __builtin_bit_cast(bf16x8, w); }
#pragma unroll
        for (int db = 0; db < 4; ++db)
#pragma unroll
            for (int kb = 0; kb < 2; ++kb)
#pragma unroll
                for (int sp = 0; sp < 2; ++sp) { const LAS unsigned long long* vp = (const LAS unsigned long long*)(buf + AT_KBYTES + (32 * db + r) * AT_VROW + 64 * kb + 32 * sp + 8 * hi);
                    const unsigned long long a0 = vp[0], a1 = vp[2]; v4u w; w.x = (unsigned)a0; w.y = (unsigned)(a0 >> 32); w.z = (unsigned)a1; w.w = (unsigned)(a1 >> 32);
                    o[db] = __builtin_amdgcn_mfma_f32_32x32x16_bf16(__builtin_bit_cast(bf16x8, w), pf[kb][sp], o[db], 0, 0, 0); }
        touch_prev = touch;
        if (i + 1 < nt) at_lstore(F.lds + ((i + 1) & 1) * AT_BUF, tid, kr, vr);
        WG_BAR();
    }
    l += __shfl_xor(l, 32);
    const float inv = 1.f / l;
    bf16* op = F.AO + (size_t)(rowbase + r) * 2048 + h * 128 + 8 * hi;
#pragma unroll
    for (int db = 0; db < 4; ++db)
#pragma unroll
        for (int gq = 0; gq < 4; gq += 2) {
            unsigned ax = pk2(o[db][4 * gq] * inv, o[db][4 * gq + 1] * inv), ay = pk2(o[db][4 * gq + 2] * inv, o[db][4 * gq + 3] * inv);
            unsigned bx = pk2(o[db][4 * gq + 4] * inv, o[db][4 * gq + 5] * inv), by = pk2(o[db][4 * gq + 6] * inv, o[db][4 * gq + 7] * inv);
            { const auto rr = __builtin_amdgcn_permlane32_swap(ax, bx, false, false); ax = rr[0]; bx = rr[1]; }
            { const auto rr = __builtin_amdgcn_permlane32_swap(ay, by, false, false); ay = rr[0]; by = rr[1]; }
            v4u w; w.x = ax; w.y = ay; w.z = bx; w.w = by;
            *(v4u*)(op + 32 * db + 8 * gq) = w; }
}
__device__ __forceinline__ void ph_attention(Frame& F) {
    const int c = (F.G == 256) ? ((F.vcu & 7) * 32 + (F.vcu >> 3)) : F.vcu;
    if (c < 256) {
        at_unit(F, 1, c >> 6, (c >> 4) & 3, c & 15);
        for (int u = 2 * c; u < 2 * c + 2; ++u) at_unit(F, 0, u >> 4, (u >> 2) & 3, u & 3);
    }
}
constexpr int RT_KROW = 528, RT_VROW = 136, RT_KBYTES = 64 * RT_KROW, RT_BUF = RT_KBYTES + 256 * RT_VROW;
__device__ __forceinline__ void rt_gload(const bf16* kp, const bf16* vtp, int L, int tid, v4u (&kr)[4], v4u (&vr)[4]) {
    const unsigned ko = (unsigned)(tid >> 5) * (unsigned)(INC * 2) + (unsigned)(tid & 31) * 16u, vo = (unsigned)(tid >> 3) * (unsigned)L * 2u + (unsigned)(tid & 7) * 16u, vs = 64u * (unsigned)L * 2u;
    const char* kc = (const char*)kp; const char* vc = (const char*)vtp;
#pragma unroll
    for (int i = 0; i < 4; ++i) { kr[i] = *(const v4u*)(kc + (ko + i * (16u * INC * 2u))); vr[i] = *(const v4u*)(vc + (vo + i * vs)); }
}
__device__ __forceinline__ void rt_lstore(LAS unsigned char* buf, int tid, const v4u (&kr)[4], const v4u (&vr)[4]) {
    LAS unsigned char* kd = buf + (tid >> 5) * RT_KROW + (tid & 31) * 16; LAS unsigned char* vd = buf + RT_KBYTES + (tid >> 3) * RT_VROW + (tid & 7) * 16;
#pragma unroll
    for (int i = 0; i < 4; ++i) {
        *(LAS v4u*)(kd + i * 16 * RT_KROW) = kr[i];
        LAS unsigned long long* vp = (LAS unsigned long long*)(vd + i * 64 * RT_VROW);
        vp[0] = (unsigned long long)vr[i].x | ((unsigned long long)vr[i].y << 32); vp[1] = (unsigned long long)vr[i].z | ((unsigned long long)vr[i].w << 32); }
}
constexpr int RT_QBYTES = 128 * RT_KROW;
__device__ __forceinline__ void rt_unit(Frame& F, int kind, int b, int h, int qb) {
    const int tid = F.tid, lane = F.lane, r = lane & 31, hi = lane >> 5, qs = F.wave & 3, vh = F.wave >> 2;
    const int L = kind ? 1024 : 256, nt = L / 64;
    const int seq0 = kind ? NCTX + b * 1024 : b * 256;
    const int qi = qb * 128 + 32 * qs + r;
    const bf16* kbase = F.P + (size_t)seq0 * INC + C_RK + h * 256;
    const bf16* vtbase = (kind ? F.VTRL + (size_t)(b * 8 + h) * 256 * 1024 : F.VTRC + (size_t)(b * 8 + h) * 256 * 256);
    const float lf2 = -__expf(F.ld_f[h]) * 1.4426950408889634f, lb2 = -__expf(F.ld_b[h]) * 1.4426950408889634f;
    LAS unsigned char* buf = F.lds + RT_QBYTES;
    LAS float* tbl = (LAS float*)(F.lds + RT_QBYTES + RT_BUF);
    const int idiag = (qb * 128 + 32 * qs) >> 6;
    if (tid < 128) { const int dir = tid >> 6, th = (tid >> 5) & 1, ix = tid & 31, koff = 32 * (ix >> 4) + (ix & 3) + 8 * ((ix & 15) >> 2) + 4 * th;
        tbl[tid] = (dir ? __builtin_amdgcn_exp2f((float)koff * lb2) : __builtin_amdgcn_exp2f((float)(63 - koff) * lf2)) * 0.0625f; }
    const LAS unsigned char* qrow = F.lds + (32 * qs + r) * RT_KROW + 16 * hi;
    { const char* qp = (const char*)(F.P + (size_t)(seq0 + qb * 128) * INC + C_RQ + h * 256); const unsigned qo = (unsigned)(tid >> 5) * (unsigned)(INC * 2) + (unsigned)(tid & 31) * 16u;
      LAS unsigned char* qd = F.lds + (tid >> 5) * RT_KROW + (tid & 31) * 16;
      v4u qv[8];
#pragma unroll
      for (int i = 0; i < 8; ++i) qv[i] = *(const v4u*)(qp + (qo + i * (16u * INC * 2u)));
      __builtin_amdgcn_sched_barrier(0);
#pragma unroll
      for (int i = 0; i < 8; ++i) *(LAS v4u*)(qd + i * 16 * RT_KROW) = qv[i]; }
    f32x16 o[4];
#pragma unroll
    for (int db = 0; db < 4; ++db)
#pragma unroll
        for (int e = 0; e < 16; ++e) o[db][e] = 0.f;
    v4u kr[4], vr[4];
    rt_gload(kbase, vtbase, L, tid, kr, vr); rt_lstore(buf, tid, kr, vr);
    __syncthreads();
    unsigned touch_prev = 0u;
#pragma unroll 1
    for (int i = 0; i < nt; ++i) {
        asm volatile("" :: "v"(touch_prev));
        if (i + 1 < nt) rt_gload(kbase + (size_t)(64 * (i + 1)) * INC, vtbase + 64 * (i + 1), L, tid, kr, vr);
        const int it2 = (i + 2 < nt) ? i + 2 : nt - 1;
        const unsigned touch = *(const unsigned*)((const char*)(kbase + (size_t)(64 * it2 + ((tid >> 2) & 63)) * INC) + (tid & 3) * 128);
        bf16x8 pf[2][2];
        const bool below = i < idiag;
        const float afac = below ? __builtin_amdgcn_exp2f((float)(qi - (64 * i + 63)) * lf2) : __builtin_amdgcn_exp2f((float)(64 * i - qi) * lb2);
        const LAS f32x4* tp = (const LAS f32x4*)(tbl + (below ? 0 : 64) + 32 * hi);
#pragma unroll
        for (int kb = 0; kb < 2; ++kb) {
            f32x16 s;
#pragma unroll
            for (int e = 0; e < 16; ++e) s[e] = 0.f;
#pragma unroll
            for (int ds = 0; ds < 16; ++ds) { const bf16x8 q = *(const LAS bf16x8*)(qrow + 32 * ds); const bf16x8 a = *(const LAS bf16x8*)(buf + (32 * kb + r) * RT_KROW + 32 * ds + 16 * hi);
                s = __builtin_amdgcn_mfma_f32_32x32x16_bf16(a, q, s, 0, 0, 0); }
            if (i == idiag) {
#pragma unroll
                for (int e = 0; e < 16; ++e) { const int kj = 64 * i + 32 * kb + (e & 3) + 8 * (e >> 2) + 4 * hi; const int d = qi - kj;
                    const float ex = d > 0 ? (float)d * lf2 : (float)(-d) * lb2; float w = __builtin_amdgcn_exp2f(ex) * 0.0625f; if (d == 0) w = 0.125f;
                    s[e] *= w; }
            } else {
#pragma unroll
                for (int e4 = 0; e4 < 4; ++e4) { const f32x4 t4 = tp[kb * 4 + e4];
                    s[4 * e4 + 0] *= afac * t4.x; s[4 * e4 + 1] *= afac * t4.y; s[4 * e4 + 2] *= afac * t4.z; s[4 * e4 + 3] *= afac * t4.w; }
            }
#pragma unroll
            for (int sp = 0; sp < 2; ++sp) { v4u w; w.x = pk2(s[8 * sp + 0], s[8 * sp + 1]); w.y = pk2(s[8 * sp + 2], s[8 * sp + 3]); w.z = pk2(s[8 * sp + 4], s[8 * sp + 5]); w.w = pk2(s[8 * sp + 6], s[8 * sp + 7]); pf[kb][sp] = __builtin_bit_cast(bf16x8, w); }
            __builtin_amdgcn_sched_barrier(0);
        }
#pragma unroll
        for (int db = 0; db < 4; ++db)
#pragma unroll
            for (int kb = 0; kb < 2; ++kb)
#pragma unroll
                for (int sp = 0; sp < 2; ++sp) { const LAS unsigned long long* vp = (const LAS unsigned long long*)(buf + RT_KBYTES + (128 * vh + 32 * db + r) * RT_VROW + 64 * kb + 32 * sp + 8 * hi);
                    const unsigned long long a0 = vp[0], a1 = vp[2]; v4u w; w.x = (unsigned)a0; w.y = (unsigned)(a0 >> 32); w.z = (unsigned)a1; w.w = (unsigned)(a1 >> 32);
                    o[db] = __builtin_amdgcn_mfma_f32_32x32x16_bf16(__builtin_bit_cast(bf16x8, w), pf[kb][sp], o[db], 0, 0, 0); if (kb == 1 && sp == 1) __builtin_amdgcn_sched_barrier(0); }
        touch_prev = touch;
        WG_BAR();
        if (i + 1 < nt) { rt_lstore(buf, tid, kr, vr); WG_BAR(); }
    }
    int oz = 0; asm volatile("" : "+v"(oz));
    if (kind) {
        const float cf = __builtin_amdgcn_exp2f((float)(qi + 1) * lf2), cb = __builtin_amdgcn_exp2f((float)(L - qi) * lb2);
#pragma unroll
        for (int dir = 0; dir < 2; ++dir) { const bf16* sp0 = (dir ? F.S0TB : F.S0TF) + ((size_t)(b * 8 + h) * 256 + 128 * vh + r + oz) * 256 + 8 * hi; const float cc = dir ? cb : cf;
#pragma unroll
            for (int db = 0; db < 4; ++db) { f32x16 acc; bf16x8 af[16];
#pragma unroll
                for (int ds = 0; ds < 16; ++ds) af[ds] = *(const bf16x8*)(sp0 + (size_t)(32 * db) * 256 + 16 * ds);
                __builtin_amdgcn_sched_barrier(0);
#pragma unroll
                for (int e = 0; e < 16; ++e) acc[e] = 0.f;
#pragma unroll
                for (int ds = 0; ds < 16; ++ds) { const bf16x8 q = *(const LAS bf16x8*)(qrow + 32 * ds); acc = __builtin_amdgcn_mfma_f32_32x32x16_bf16(af[ds], q, acc, 0, 0, 0); }
#pragma unroll
                for (int e = 0; e < 16; ++e) o[db][e] += cc * acc[e];
                __builtin_amdgcn_sched_barrier(0); } }
    }
    const int row = seq0 + qi + oz;
    const bf16* gp = F.P + (size_t)row * INC + C_RG + h * 256 + 128 * vh + 4 * hi;
    unsigned long long g2v[16];
#pragma unroll
    for (int db = 0; db < 4; ++db)
#pragma unroll
        for (int gq = 0; gq < 4; ++gq) g2v[db * 4 + gq] = *(const unsigned long long*)(gp + 32 * db + 8 * gq);
    const float* gwp0 = F.gn_w + h * 256 + 128 * vh + 4 * hi + oz; f32x4 gwv[16];
#pragma unroll
    for (int k = 0; k < 16; ++k) gwv[k] = *(const f32x4*)(gwp0 + 8 * k);
    __builtin_amdgcn_sched_barrier(0);
    float ss = 0.f;
#pragma unroll
    for (int db = 0; db < 4; ++db)
#pragma unroll
        for (int e = 0; e < 16; ++e) ss += o[db][e] * o[db][e];
    ss += __shfl_xor(ss, 32);
    LAS float* red = (LAS float*)buf;
    if (hi == 0) red[(vh * 4 + qs) * 32 + r] = ss;
    __syncthreads();
    const float tot = red[qs * 32 + r] + red[(4 + qs) * 32 + r];
    const float rstd = rsqrtf(tot * (1.f / 256.f) + EPS);
    const float* gwp = F.gn_w + h * 256 + 128 * vh + 4 * hi;
    bf16* op = F.RO + (size_t)row * 2048 + h * 256 + 128 * vh + 8 * hi;
#pragma unroll
    for (int db = 0; db < 4; ++db)
#pragma unroll
        for (int gq = 0; gq < 4; gq += 2) { unsigned pkd[2][2];
#pragma unroll
            for (int t = 0; t < 2; ++t) { const int g = gq + t, dc = 32 * db + 8 * g;
                const unsigned long long g2 = g2v[db * 4 + g]; const unsigned g_lo = (unsigned)g2, g_hi = (unsigned)(g2 >> 32);
                const f32x4 gw4 = gwv[db * 4 + g];
                const float y0 = silu_f(bflo(g_lo)) * (o[db][4 * g] * rstd * gw4.x), y1 = silu_f(bfhi(g_lo)) * (o[db][4 * g + 1] * rstd * gw4.y), y2 = silu_f(bflo(g_hi)) * (o[db][4 * g + 2] * rstd * gw4.z), y3 = silu_f(bfhi(g_hi)) * (o[db][4 * g + 3] * rstd * gw4.w);
                pkd[t][0] = pk2(y0, y1); pkd[t][1] = pk2(y2, y3); }
            { const auto rr = __builtin_amdgcn_permlane32_swap(pkd[0][0], pkd[1][0], false, false); pkd[0][0] = rr[0]; pkd[1][0] = rr[1]; }
            { const auto rr = __builtin_amdgcn_permlane32_swap(pkd[0][1], pkd[1][1], false, false); pkd[0][1] = rr[0]; pkd[1][1] = rr[1]; }
            v4u w; w.x = pkd[0][0]; w.y = pkd[0][1]; w.z = pkd[1][0]; w.w = pkd[1][1];
            *(v4u*)(op + 32 * db + 8 * gq) = w; }
    __syncthreads();
}
__device__ __forceinline__ void ph_retention(Frame& F) {
    const int c = (F.G == 256) ? ((F.vcu & 7) * 32 + (F.vcu >> 3)) : F.vcu;
    if (c < 256) {
        rt_unit(F, 1, c >> 6, (c >> 3) & 7, c & 7);
        for (int u = 2 * c; u < 2 * c + 2; ++u) rt_unit(F, 0, u >> 4, (u >> 1) & 7, u & 1);
    }
}
__device__ __forceinline__ void ph_mix(Frame& F) {
    const size_t total = (size_t)NTOK * (D / 8);
    for (size_t i = (size_t)F.vcu * NTHR + F.tid; i < total; i += (size_t)F.G * NTHR) {
        const int r = (int)(i / (D / 8)), c8 = (int)(i % (D / 8)) * 8;
        float t1[8], t2[8], gr[8], ga[8], o[8];
        unpack8(*(const v4u*)(F.T1 + (size_t)r * D + c8), t1); unpack8(*(const v4u*)(F.T2 + (size_t)r * D + c8), t2);
        unpack8(*(const v4u*)(F.P + (size_t)r * INC + C_GR + c8), gr); unpack8(*(const v4u*)(F.P + (size_t)r * INC + C_GA + c8), ga);
#pragma unroll
        for (int e = 0; e < 8; ++e) o[e] = sigm_f(gr[e]) * t1[e] + sigm_f(ga[e]) * t2[e];
        *(v4u*)(F.MIX + (size_t)r * D + c8) = pack8(o);
    }
}
__device__ __forceinline__ f32x4 ld4bf(const bf16* p) { const unsigned long long w = *(const unsigned long long*)p; const unsigned lo = (unsigned)w, hi = (unsigned)(w >> 32); return (f32x4){bflo(lo), bfhi(lo), bflo(hi), bfhi(hi)}; }
__device__ __forceinline__ void st4bf(bf16* p, const f32x4 y) { *(unsigned long long*)p = (unsigned long long)pk2(y.x, y.y) | ((unsigned long long)pk2(y.z, y.w) << 32); }
__device__ __forceinline__ void ph_rowA(Frame& F) {
    const int gw = F.vcu * NWAVES + F.wave, NGW = F.G * NWAVES, lane = F.lane;
    for (int r = gw; r < NTOK; r += NGW) {
        const bf16* mo = F.MO + (size_t)r * D + 4 * lane; const f32x4* xr = (const f32x4*)xrow(F, r) + lane;
        const float* md = F.mods + (size_t)cond_of(r) * MODC;
        f32x4 v[16], xv[16]; float ss = 0.f;
#pragma unroll
        for (int j = 0; j < 16; ++j) { v[j] = ld4bf(mo + 256 * j); xv[j] = xr[64 * j]; }
#pragma unroll
        for (int j = 0; j < 16; ++j) ss += (v[j].x * v[j].x + v[j].y * v[j].y) + (v[j].z * v[j].z + v[j].w * v[j].w);
        const float rstd1 = rsqrtf(wave_sum(ss) * (1.f / D) + EPS);
        float ss2 = 0.f;
#pragma unroll
        for (int jb = 0; jb < 16; jb += 4) { f32x4 w[4], g[4];
#pragma unroll
            for (int q = 0; q < 4; ++q) { const int col = 4 * (lane + 64 * (jb + q)); w[q] = *(const f32x4*)(F.n_mix_post + col); g[q] = *(const f32x4*)(md + 2 * D + col); }
            __builtin_amdgcn_sched_barrier(0);
#pragma unroll
            for (int q = 0; q < 4; ++q) { const int j = jb + q, col = 4 * (lane + 64 * j);
                v[j] = xv[j] + g[q] * (v[j] * rstd1 * w[q]); ss2 += (v[j].x * v[j].x + v[j].y * v[j].y) + (v[j].z * v[j].z + v[j].w * v[j].w);
                st4bf(F.X1 + (size_t)r * D + col, v[j]); }
            __builtin_amdgcn_sched_barrier(0); }
        const float rstd2 = rsqrtf(wave_sum(ss2) * (1.f / D) + EPS);
#pragma unroll
        for (int jb = 0; jb < 16; jb += 4) { f32x4 w[4], sh[4], sc[4];
#pragma unroll
            for (int q = 0; q < 4; ++q) { const int col = 4 * (lane + 64 * (jb + q)); w[q] = *(const f32x4*)(F.n_ffn_pre + col); sh[q] = *(const f32x4*)(md + 3 * D + col); sc[q] = *(const f32x4*)(md + 4 * D + col); }
            __builtin_amdgcn_sched_barrier(0);
#pragma unroll
            for (int q = 0; q < 4; ++q) { const int col = 4 * (lane + 64 * (jb + q)); st4bf(F.H2 + (size_t)r * D + col, (v[jb + q] * rstd2 * w[q]) * (1.f + sc[q]) + sh[q]); }
            __builtin_amdgcn_sched_barrier(0); }
    }
}
__device__ __forceinline__ void ph_rowB(Frame& F) {
    const int gw = F.vcu * NWAVES + F.wave, NGW = F.G * NWAVES, lane = F.lane;
    for (int r = gw; r < NTOK; r += NGW) {
        const bf16* ff = F.FF + (size_t)r * D + 4 * lane; const bf16* x1 = F.X1 + (size_t)r * D + 4 * lane;
        const float* md = F.mods + (size_t)cond_of(r) * MODC;
        f32x4 v[16]; unsigned long long xw[16]; float ss = 0.f;
#pragma unroll
        for (int j = 0; j < 16; ++j) { v[j] = ld4bf(ff + 256 * j); xw[j] = *(const unsigned long long*)(x1 + 256 * j); }
#pragma unroll
        for (int j = 0; j < 16; ++j) ss += (v[j].x * v[j].x + v[j].y * v[j].y) + (v[j].z * v[j].z + v[j].w * v[j].w);
        const float rstd = rsqrtf(wave_sum(ss) * (1.f / D) + EPS);
#pragma unroll
        for (int jb = 0; jb < 16; jb += 4) { f32x4 w[4], g[4];
#pragma unroll
            for (int q = 0; q < 4; ++q) { const int col = 4 * (lane + 64 * (jb + q)); w[q] = *(const f32x4*)(F.n_ffn_post + col); g[q] = *(const f32x4*)(md + 5 * D + col); }
            __builtin_amdgcn_sched_barrier(0);
#pragma unroll
            for (int q = 0; q < 4; ++q) { const int j = jb + q, col = 4 * (lane + 64 * j); const unsigned xl = (unsigned)xw[j], xh = (unsigned)(xw[j] >> 32);
                const f32x4 x = (f32x4){bflo(xl), bfhi(xl), bflo(xh), bfhi(xh)};
                __builtin_nontemporal_store(x + g[q] * (v[j] * rstd * w[q]), (f32x4*)(F.out + O_Y + (size_t)r * D + col)); }
            __builtin_amdgcn_sched_barrier(0); }
    }
}
struct StateOrder { int G, c;
    __device__ bool next(int i, pg8::Unit& u) const { const int idx = i * G + c; if (idx >= 512) return false; u.pm = idx; u.pn = idx >> 1; return true; }
    __device__ __forceinline__ void a_ready(const pg8::Unit&) const {}
    __device__ __forceinline__ void done(const pg8::Unit&) const {}
};
struct EpiState { static constexpr bool PERM = false, AFTER_DRAIN = false; float* out;
    __device__ __forceinline__ void operator()(const pg8::f32x4 (&acc)[2][2][4][2], const pg8::Unit& u, int wr, int wc, int fr, int fq) const {
        int loff = (wr * 64 + fr) * 256 + wc * 32 + 4 * fq; asm volatile("" : "+v"(loff));
        float* base = out + ((u.pm & 1) ? O_SB : O_SF) + (size_t)u.pn * 65536 + loff;
#pragma unroll
        for (int ai = 0; ai < 2; ++ai)
#pragma unroll
            for (int m = 0; m < 4; ++m) { float* rowp = base + (ai * pg8::HALF + m * 16) * 256;
#pragma unroll
                for (int bj = 0; bj < 2; ++bj)
#pragma unroll
                    for (int n = 0; n < 2; ++n) __builtin_nontemporal_store(acc[ai][bj][m][n], (pg8::f32x4*)(rowp + bj * pg8::HALF + n * 16)); }
    }
};
struct EpiSwiglu { static constexpr bool PERM = true, AFTER_DRAIN = false; bf16* O;
    __device__ __forceinline__ void operator()(const pg8::f32x4 (&acc)[2][2][4][2], const pg8::Unit& u, int wr, int wc, int fr, int fq) const {
        int loff = (u.pm * pg8::BM + wr * 64 + fr) * FFN + u.pn * 128 + wc * 32 + 8 * fq; asm volatile("" : "+v"(loff));
        bf16* base = O + loff;
#pragma unroll
        for (int ai = 0; ai < 2; ++ai)
#pragma unroll
            for (int m = 0; m < 4; ++m) { const pg8::f32x4 a0 = acc[ai][0][m][0], a1 = acc[ai][0][m][1], b0 = acc[ai][1][m][0], b1 = acc[ai][1][m][1];
                v4u w; w.x = pk2(silu_f(a0[0]) * b0[0], silu_f(a0[1]) * b0[1]); w.y = pk2(silu_f(a0[2]) * b0[2], silu_f(a0[3]) * b0[3]);
                w.z = pk2(silu_f(a1[0]) * b1[0], silu_f(a1[1]) * b1[1]); w.w = pk2(silu_f(a1[2]) * b1[2], silu_f(a1[3]) * b1[3]);
                *(v4u*)(base + (size_t)(ai * pg8::HALF + m * 16) * FFN) = w; }
    }
};
template <bool ADD> struct EpiGate { static constexpr bool PERM = true, AFTER_DRAIN = false; bf16* O; const bf16* gate; const bf16* add;
    __device__ __forceinline__ void operator()(const pg8::f32x4 (&acc)[2][2][4][2], const pg8::Unit& u, int wr, int wc, int fr, int fq) const {
        const int row0 = u.pm * pg8::BM + wr * 64 + fr, col0 = u.pn * pg8::BM + wc * 32 + 8 * fq;
#pragma unroll
        for (int ai = 0; ai < 2; ++ai) {
            v4u gv[4][2], tv[4][2];
#pragma unroll
            for (int m = 0; m < 4; ++m)
#pragma unroll
                for (int bj = 0; bj < 2; ++bj) { const size_t r = (size_t)(row0 + ai * pg8::HALF + m * 16); const int c = col0 + bj * pg8::HALF;
                    gv[m][bj] = *(const v4u*)(gate + r * INC + c); if (ADD) tv[m][bj] = *(const v4u*)(add + r * D + c); }
            __builtin_amdgcn_sched_barrier(0);
#pragma unroll
            for (int m = 0; m < 4; ++m)
#pragma unroll
                for (int bj = 0; bj < 2; ++bj) { const size_t r = (size_t)(row0 + ai * pg8::HALF + m * 16); const int c = col0 + bj * pg8::HALF; float g[8], t[8], o[8];
                    unpack8(gv[m][bj], g);
                    if (ADD) unpack8(tv[m][bj], t);
                    const pg8::f32x4 v0 = acc[ai][bj][m][0], v1 = acc[ai][bj][m][1];
#pragma unroll
                    for (int e = 0; e < 4; ++e) { o[e] = sigm_f(g[e]) * v0[e]; o[4 + e] = sigm_f(g[4 + e]) * v1[e]; }
                    if (ADD) {
#pragma unroll
                        for (int e = 0; e < 8; ++e) o[e] += t[e]; }
                    *(v4u*)(O + r * D + c) = pack8(o); }
            __builtin_amdgcn_sched_barrier(0);
        }
    }
};
struct BlockOrder { int nfull, nblk, x, l, rev;
    __device__ void init(int nN, int c, int rev_ = 0) { nfull = nN / 4; nblk = 6 * nfull + ((nN & 3) ? 3 : 0); x = c & 7; l = c >> 3; rev = rev_; }
    __device__ bool next(int i, pg8::Unit& u) const { const int k = i * 8 + x; if (k >= nblk) return false;
        if (k < 6 * nfull) { int cb = k / 6; const int rb = k - 6 * cb; if (rev) cb = nfull - 1 - cb; u.pm = 8 * rb + (l & 7); u.pn = 4 * cb + (l >> 3); }
        else { const int rb = k - 6 * nfull; u.pm = 16 * rb + (l & 15); u.pn = 4 * nfull + (l >> 4); }
        return true; }
    __device__ __forceinline__ void a_ready(const pg8::Unit&) const {}
    __device__ __forceinline__ void done(const pg8::Unit&) const {}
};
struct Args { const float* in[24]; float* out; unsigned char* ws; int ph_lo, ph_hi, flags, pad; };
__global__ void __launch_bounds__(NTHR, 2) mk_fwd(Args args) {
    extern __shared__ __attribute__((aligned(16))) unsigned char lds[];
    Frame F;
    F.lds = (LAS unsigned char*)lds;
    F.MISC = (volatile LAS unsigned*)(F.lds + MISC_OFF);
    F.tid = threadIdx.x; F.lane = F.tid & 63; F.wave = __builtin_amdgcn_readfirstlane(F.tid >> 6);
    F.G = gridDim.x; F.vcu = blockIdx.x; F.flags = args.flags;
    unsigned char* ws = args.ws;
    F.ctl = (gu32*)(ws + WS_CTL);
    F.xp = args.in[0]; F.xs = args.in[1]; F.cache_k = args.in[2]; F.cache_v = args.in[3]; F.st_f = args.in[4]; F.st_b = args.in[5]; F.c = args.in[6]; F.c_ctx = args.in[7];
    F.w_mod = args.in[8]; F.b_mod = args.in[9]; F.n_mix_pre = args.in[10]; F.n_mix_post = args.in[11]; F.n_ffn_pre = args.in[12]; F.n_ffn_post = args.in[13];
    F.w_in = args.in[14]; F.ld_f = args.in[15]; F.ld_b = args.in[16]; F.gn_w = args.in[17]; F.sink = args.in[18]; F.w_br = args.in[19]; F.w_ba = args.in[20];
    F.w_out = args.in[21]; F.w_up = args.in[22]; F.w_dn = args.in[23]; F.out = args.out;
    F.mods = (float*)(ws + WS_MODS); F.mpart = (float*)(ws + WS_MPART);
    F.Win_t = (bf16*)(ws + WS_WIN); F.Wbr_t = (bf16*)(ws + WS_WBR); F.Wba_t = (bf16*)(ws + WS_WBA); F.Wout_t = (bf16*)(ws + WS_WOUT); F.Wup_t = (bf16*)(ws + WS_WUP); F.Wdn_t = (bf16*)(ws + WS_WDN);
    F.P = (bf16*)(ws + WS_R1); F.MO = (bf16*)(ws + WS_R1); F.UA = (bf16*)(ws + WS_R1); F.UB = F.UA + (size_t)NTOK * FFN;
    F.H1 = (bf16*)(ws + WS_R2); F.OF = (float*)(ws + WS_R2); F.OB = F.OF + (size_t)NTOK * 2048; F.T1 = (bf16*)(ws + WS_R2); F.T2 = F.T1 + (size_t)NTOK * D; F.X1 = (bf16*)(ws + WS_R2);
    F.RO = (bf16*)(ws + WS_R3); F.AO = F.RO + (size_t)NTOK * 2048; F.MIX = F.RO + (size_t)NTOK * D; F.H2 = (bf16*)(ws + WS_R3); F.FF = (bf16*)(ws + WS_R3 + 96 * MiB);
    F.VTRC = (bf16*)(ws + WS_R2); F.VTRL = (bf16*)(ws + WS_R2 + 32 * MiB); F.KT = (bf16*)(ws + WS_R2 + 48 * MiB); F.S0TF = (bf16*)(ws + WS_R2 + 176 * MiB); F.S0TB = (bf16*)(ws + WS_R2 + 180 * MiB);
    F.VT = (bf16*)(ws + WS_R3 + 96 * MiB); F.CK = (bf16*)(ws + WS_R3 + 112 * MiB); F.CVT = (bf16*)(ws + WS_R3 + 116 * MiB);
    for (int u = F.tid; u < (LDS_BYTES - LDSCTL_OFF) / 4; u += NTHR) ((LAS unsigned*)(F.lds + LDSCTL_OFF))[u] = 0u;
    __syncthreads();
    XcdBarrier bar; bar.bar = (unsigned*)(F.ctl + CW_BAR); bar.x = 0; bar.st = nullptr;
    if (MK_ONE_LAUNCH) bar = xcd_barrier_post((unsigned*)(F.ctl + CW_BAR), F.MISC + 8);
    const int lo = args.ph_lo, hi = args.ph_hi;
#define IN(k) (lo <= (k) && (k) < hi)
#define SEAM(k) do { if (IN(k) && IN((k) + 1)) xcd_barrier(bar); } while (0)
    if (IN(0)) { ph_mods_partial(F, 0, 4, F.vcu, F.G); ph_convert(F, 0, F.vcu, F.G); ph_cache(F); ph_s0t(F); } SEAM(0);
    if (IN(2)) { ph_h1(F); } SEAM(2);
    if (IN(3)) { pg8::Gemm g{F.H1, F.Win_t, NTOK, INC, D}; pg8::EpiBf16<0> E{F.P, INC, nullptr, 0, 0, 1.f};
        if (F.G == 256) { BlockOrder S; S.init(INC / 256, (int)blockIdx.x, 1); pg8::gemm_phase<pg8::EpiBf16<0>, BlockOrder, true, true>(F.lds, g, S, E);
            constexpr int lastx = (6 * (INC / 1024)) % 8; const int x = (int)blockIdx.x & 7, l = (int)blockIdx.x >> 3;
            if (x >= lastx) { const int rank = (x - lastx) * 32 + l, n = (8 - lastx) * 32; ph_mods_partial(F, 4, 10, rank, n); ph_convert(F, 1, rank, n); } }
        else { pg8::StaticOrder S; S.init(NTOK, INC, F.G, (int)blockIdx.x); pg8::gemm_phase<pg8::EpiBf16<0>, pg8::StaticOrder, true, true>(F.lds, g, S, E); ph_mods_partial(F, 4, 10, F.vcu, F.G); ph_convert(F, 1, F.vcu, F.G); } } SEAM(3);
    if (IN(4)) { ph_post(F); }
    if (IN(8)) { ph_transposes(F); } if (IN(8) && IN(5)) xcd_barrier(bar);
    if (IN(5)) { ph_retention(F); }
    if (IN(6)) { { pg8::Gemm g{F.KT, F.VTRC, 512 * 256, 256 * 256, 256}; StateOrder S{F.G, (int)blockIdx.x}; EpiState E{F.out};
          pg8::gemm_phase<EpiState, StateOrder, true, true>(F.lds, g, S, E); }
        ph_attention(F); } SEAM(6);
    if (IN(7)) {
        { pg8::Gemm g{F.RO, F.Wbr_t, NTOK, D, 2048}; pg8::StaticOrder S; S.init(NTOK, D, F.G, (int)blockIdx.x); EpiGate<false> E{F.T1, F.P + C_GR, nullptr};
          pg8::gemm_phase<EpiGate<false>, pg8::StaticOrder, true, true>(F.lds, g, S, E); }
        { pg8::Gemm g{F.AO, F.Wba_t, NTOK, D, 2048}; pg8::StaticOrder S; S.init(NTOK, D, F.G, (int)blockIdx.x); EpiGate<true> E{F.MIX, F.P + C_GA, F.T1};
          pg8::gemm_phase<EpiGate<true>, pg8::StaticOrder, true, true>(F.lds, g, S, E); } } SEAM(7);
    if (IN(9)) { pg8::Gemm g{F.MIX, F.Wout_t, NTOK, D, D}; pg8::StaticOrder S; S.init(NTOK, D, F.G, (int)blockIdx.x); pg8::EpiBf16<0> E{F.MO, D, nullptr, 0, 0, 1.f};
        pg8::gemm_phase<pg8::EpiBf16<0>, pg8::StaticOrder, true, true>(F.lds, g, S, E); } SEAM(9);
    if (IN(10)) { ph_rowA(F); } SEAM(10);
    if (IN(11)) { pg8::Gemm g{F.H2, F.Wup_t, NTOK, 2 * FFN, D}; EpiSwiglu E{F.UA};
        if (F.G == 256) { BlockOrder S; S.init(2 * FFN / 256, (int)blockIdx.x); pg8::gemm_phase<EpiSwiglu, BlockOrder, true, true>(F.lds, g, S, E);
            constexpr int nblk = 6 * (2 * FFN / 1024) + (((2 * FFN / 256) & 3) ? 3 : 0), lastx = nblk % 8; const int x = (int)blockIdx.x & 7, l = (int)blockIdx.x >> 3;
            if (x >= lastx) { const int rank = (x - lastx) * 32 + l, n = (8 - lastx) * 32; ph_mods_partial(F, 10, 12, rank, n); ph_convert(F, 2, rank, n); } }
        else { pg8::StaticOrder S; S.init(NTOK, 2 * FFN, F.G, (int)blockIdx.x); pg8::gemm_phase<EpiSwiglu, pg8::StaticOrder, true, true>(F.lds, g, S, E); ph_mods_partial(F, 10, 12, F.vcu, F.G); ph_convert(F, 2, F.vcu, F.G); } } SEAM(11);
    if (IN(13)) { pg8::Gemm g{F.UA, F.Wdn_t, NTOK, D, FFN}; pg8::StaticOrder S; S.init(NTOK, D, F.G, (int)blockIdx.x); pg8::EpiBf16<0> E{F.FF, D, nullptr, 0, 0, 1.f};
        pg8::gemm_phase<pg8::EpiBf16<0>, pg8::StaticOrder, true, true>(F.lds, g, S, E); } SEAM(13);
    if (IN(14)) { ph_rowB(F); }
#undef IN
#undef SEAM
}

extern "C" void kernel_launch(void* const* d_in, const int* in_sizes, int n_in, void* d_out, int out_size, void* d_ws, size_t ws_size, hipStream_t stream) {
    static int grid = 0;
    if (grid == 0) {
        if (n_in != 24 || out_size != (int)O_END || ws_size < WS_END) { fprintf(stderr, "kernel_launch: unexpected shapes (n_in %d out %d ws %zu)\n", n_in, out_size, ws_size); grid = -1; return; }
        int dev = 0, cus = 0, per_cu = 0;
        if (hipGetDevice(&dev) != hipSuccess || hipDeviceGetAttribute(&cus, hipDeviceAttributeMultiprocessorCount, dev) != hipSuccess) { grid = -1; return; }
        if (hipFuncSetAttribute((const void*)mk_fwd, hipFuncAttributeMaxDynamicSharedMemorySize, LDS_BYTES) != hipSuccess) { grid = -1; return; }
        if (hipOccupancyMaxActiveBlocksPerMultiprocessor(&per_cu, (const void*)mk_fwd, NTHR, LDS_BYTES) != hipSuccess || per_cu < 1) { fprintf(stderr, "kernel_launch: occupancy query says %d\n", per_cu); }
        (void)hipGetLastError();
        grid = cus;
        if (grid != 256) { fprintf(stderr, "kernel_launch: expected 256 CUs, got %d\n", grid); }
    }
    if (grid < 0) return;
    (void)hipMemsetAsync((char*)d_ws + WS_CTL, 0, CTL_ZERO_BYTES, stream);
    Args a{};
    for (int i = 0; i < 24; ++i) a.in[i] = (const float*)d_in[i];
    a.out = (float*)d_out; a.ws = (unsigned char*)d_ws;
#if MK_ONE_LAUNCH
    a.ph_lo = 0; a.ph_hi = NPHASE;
    hipLaunchKernelGGL(mk_fwd, dim3(grid), dim3(NTHR), LDS_BYTES, stream, a);
#else
    for (int p = 0; p < NPHASE; ++p) { a.ph_lo = p; a.ph_hi = p + 1; hipLaunchKernelGGL(mk_fwd, dim3(grid), dim3(NTHR), LDS_BYTES, stream, a); }
#endif
}
```

```cpp
#include <hip/hip_runtime.h>
#include <cstdio>
#include <cstdint>
namespace pg8 {
#define PG8_LAS __attribute__((address_space(3)))
typedef unsigned short bf16_t;
typedef short bf16x8 __attribute__((ext_vector_type(8)));
typedef float f32x4 __attribute__((ext_vector_type(4)));
typedef unsigned u32x4 __attribute__((ext_vector_type(4)));
constexpr int BM = 256, BK = 64, HALF = 128, HTB = HALF * BK * 2  , STAGE_BYTES = 8 * HTB, NXCD = 8, WGM = 8;

__host__ __device__ __forceinline__ int lds_byte(int r, int c) { const int st = (r >> 4) * 2 + (c >> 5), rr = r & 15, cc = c & 31, ob = rr * 64 + cc * 2; return st * 1024 + (ob ^ (((ob >> 9) & 1) << 5)); }
__host__ __device__ __forceinline__ void stage_rc(int b, int& R, int& C) { const int st = b / 1024, sb = b % 1024, swz = sb ^ (((sb >> 9) & 1) << 5); R = (st >> 1) * 16 + swz / 64; C = (st & 1) * 32 + (swz % 64) / 2; }
__host__ __device__ __forceinline__ int perm32(int rho) { const int n = rho >> 4, i = rho & 15; return 8 * (i >> 2) + 4 * n + (i & 3); }

struct Unit { int pm, pn; };
struct Gemm { const bf16_t* A; const bf16_t* Bt; int M, N, K; };

struct StaticOrder {
    int nM, nN, nwg, G, c;
    __host__ __device__ void init(int M, int N, int G_, int c_) { nM = M / BM; nN = N / BM; nwg = nM * nN; G = G_; c = c_; }
    __host__ __device__ bool next(int i, Unit& u) const {
        const long L = (long)i * G + c; if (L >= nwg) return false;
        int wgid = (int)L; { const int q = nwg / NXCD, r = nwg % NXCD, xcd = wgid % NXCD, off = wgid / NXCD; wgid = (xcd < r ? xcd * (q + 1) : r * (q + 1) + (xcd - r) * q) + off; }
        const int nig = WGM * nN, gid = wgid / nig, fm = gid * WGM, gsz = (nM - fm) < WGM ? (nM - fm) : WGM;
        u.pm = fm + ((wgid % nig) % gsz); u.pn = (wgid % nig) / gsz; return true;
    }
    __device__ __forceinline__ void a_ready(const Unit&) const {}
    __device__ __forceinline__ void done(const Unit&) const {}
};

__device__ __forceinline__ unsigned cvt_pk_bf16(float lo, float hi) { unsigned r; asm volatile("v_cvt_pk_bf16_f32 %0, %1, %2" : "=v"(r) : "v"(lo), "v"(hi)); return r; }
typedef float f32x2 __attribute__((ext_vector_type(2)));
__device__ __forceinline__ f32x2 gelu_pk(f32x2 v) {
    const f32x2 av = __builtin_elementwise_abs(v), d = av * 0.2316418882f + 1.0f;
    f32x2 t; t.x = __builtin_amdgcn_rcpf(d.x); t.y = __builtin_amdgcn_rcpf(d.y);
    f32x2 q = t * 0.5307027145f + (-0.7265760135f); q = q * t + 0.7107068705f; q = q * t + (-0.142248368f); q = q * t + 0.127414796f; q = q * t;
    const f32x2 s = (v * v) * (-0.72134752044f);
    f32x2 e; e.x = __builtin_amdgcn_exp2f(s.x); e.y = __builtin_amdgcn_exp2f(s.y);
    const f32x2 m = v * (q * e), r = v - m;
    f32x2 o; o.x = v.x < 0.f ? m.x : r.x; o.y = v.y < 0.f ? m.y : r.y; return o;
}

template <int ACT  > struct EpiBf16 {
    static constexpr bool PERM = true, AFTER_DRAIN = false; static_assert(ACT == 0 || ACT == 1, "EpiBf16: ACT is 0 (none) or 1 (gelu_pk)");
    bf16_t* O; int ldc; const float* bias; int split_cols; size_t split_stride; float scale0;
    __device__ __forceinline__ void operator()(const f32x4 (&acc)[2][2][4][2], const Unit& u, int wr, int wc, int fr, int fq) const {
        const int row0 = u.pm * BM + wr * 64 + fr; int colt = u.pn * BM; bf16_t* base = O;
        float sc = 1.f; if (split_cols) { const int t = colt / split_cols; base += (size_t)t * split_stride; colt -= t * split_cols; if (t == 0) sc = scale0; }
        const int col0 = colt + wc * 32 + 8 * fq, bcol0 = u.pn * BM + wc * 32 + 8 * fq;
        f32x4 bv[2][2];
#pragma unroll
        for (int bj = 0; bj < 2; ++bj)
#pragma unroll
            for (int n = 0; n < 2; ++n) bv[bj][n] = bias ? *(const f32x4*)(bias + bcol0 + bj * HALF + 4 * n) : (f32x4){0.f, 0.f, 0.f, 0.f};
#pragma unroll
        for (int ai = 0; ai < 2; ++ai)
#pragma unroll
            for (int m = 0; m < 4; ++m) { bf16_t* rowp = base + (size_t)(row0 + ai * HALF + m * 16) * ldc + col0;
#pragma unroll
                for (int bj = 0; bj < 2; ++bj) { f32x4 v0 = acc[ai][bj][m][0] + bv[bj][0], v1 = acc[ai][bj][m][1] + bv[bj][1];
                    if (ACT == 1) { f32x2 a = gelu_pk((f32x2){v0[0], v0[1]}), b = gelu_pk((f32x2){v0[2], v0[3]}), c = gelu_pk((f32x2){v1[0], v1[1]}), d = gelu_pk((f32x2){v1[2], v1[3]});
                        v0 = (f32x4){a.x, a.y, b.x, b.y}; v1 = (f32x4){c.x, c.y, d.x, d.y}; }
                    v0 = v0 * sc; v1 = v1 * sc; u32x4 w; w.x = cvt_pk_bf16(v0[0], v0[1]); w.y = cvt_pk_bf16(v0[2], v0[3]); w.z = cvt_pk_bf16(v1[0], v1[1]); w.w = cvt_pk_bf16(v1[2], v1[3]);
                    *(u32x4*)(rowp + bj * HALF) = w; } }
    }
};
struct EpiF32 {
    static constexpr bool PERM = false, AFTER_DRAIN = false;
    float* C; int ldc;
    __device__ __forceinline__ void operator()(const f32x4 (&acc)[2][2][4][2], const Unit& u, int wr, int wc, int fr, int fq) const {
        const int row0 = u.pm * BM + wr * 64 + fr, col0 = u.pn * BM + wc * 32 + 4 * fq;
#pragma unroll
        for (int ai = 0; ai < 2; ++ai)
#pragma unroll
            for (int m = 0; m < 4; ++m) { float* rowp = C + (size_t)(row0 + ai * HALF + m * 16) * ldc + col0;
#pragma unroll
                for (int bj = 0; bj < 2; ++bj)
#pragma unroll
                    for (int n = 0; n < 2; ++n) *(f32x4*)(rowp + bj * HALF + n * 16) = acc[ai][bj][m][n]; }
    }
};
template <class Epi, class Sched, bool ALIGN_EPI = false, bool SP2 = false>
__device__ __forceinline__ void gemm_phase(PG8_LAS unsigned char* lds, const Gemm g, const Sched& S, const Epi& E) {
    const int tid = threadIdx.x, wid = __builtin_amdgcn_readfirstlane(tid >> 6), lane = tid & 63, wr = wid >> 2, wc = wid & 3, fr = lane & 15, fq = lane >> 4;
    const int K = g.K, nt = K / BK;
    unsigned voffA[2], voffB[2];
#pragma unroll
    for (int i = 0; i < 2; ++i) { int R, C; stage_rc(tid * 16 + i * 8192, R, C); const int Rb = Epi::PERM ? ((R & ~31) + perm32(R & 31)) : R;
        voffA[i] = (unsigned)(R * K + C) * 2u; voffB[i] = (unsigned)(Rb * K + C) * 2u; }
    const size_t kstep = (size_t)(BK * 2);
    const size_t hstep = (size_t)HALF * K * 2;
    const size_t tstep = 2 * hstep;
    const unsigned ldsw = (unsigned)wid * 1024u;
    const int aoff = lds_byte(wr * 64 + fr, fq * 8), boff = lds_byte(wc * 32 + fr, fq * 8);
#define PG8_SA(b, h) (((b) * 2 + (h)) * HTB)
#define PG8_SB(b, h) ((4 + (b) * 2 + (h)) * HTB)
#define PG8_STAGE(bufoff, gbase, voff) do { _Pragma("unroll") for (int _i = 0; _i < 2; ++_i) \
        __builtin_amdgcn_global_load_lds((const unsigned*)((const char*)(gbase) + (voff)[_i]), (PG8_LAS unsigned*)(lds + (bufoff) + ldsw + _i * 8192), 16, 0, 0); } while (0)
#define PG8_LDA(dst, b, h) do { _Pragma("unroll") for (int m = 0; m < 4; ++m) _Pragma("unroll") for (int k = 0; k < 2; ++k) dst[m][k] = *(const PG8_LAS bf16x8*)(lds + PG8_SA(b, h) + aoff + m * 2048 + k * 1024); } while (0)
#define PG8_LDB(dst, b, h) do { _Pragma("unroll") for (int n = 0; n < 2; ++n) _Pragma("unroll") for (int k = 0; k < 2; ++k) dst[n][k] = *(const PG8_LAS bf16x8*)(lds + PG8_SB(b, h) + boff + n * 2048 + k * 1024); } while (0)
#define PG8_MMA(ai, bj, At, Bt) do { __builtin_amdgcn_s_setprio(1); _Pragma("unroll") for (int m = 0; m < 4; ++m) _Pragma("unroll") for (int n = 0; n < 2; ++n) _Pragma("unroll") for (int k = 0; k < 2; ++k) \
        acc[ai][bj][m][n] = __builtin_amdgcn_mfma_f32_16x16x32_bf16(Bt[n][k], At[m][k], acc[ai][bj][m][n], 0, 0, 0); __builtin_amdgcn_s_setprio(0); } while (0)
#define PG8_WAIT_V(n) asm volatile("s_waitcnt vmcnt(" #n ")" ::: "memory")
#define PG8_WAIT_L(n) asm volatile("s_waitcnt lgkmcnt(" #n ")" ::: "memory")
#define PG8_BAR __builtin_amdgcn_s_barrier()
#define PG8_SCHED __builtin_amdgcn_sched_barrier(0)
    Unit cur, nxt; int ui = 0;
    if (!S.next(0, cur)) return;
    f32x4 acc[2][2][4][2];
#pragma unroll
    for (int a = 0; a < 2; ++a)
#pragma unroll
        for (int b = 0; b < 2; ++b)
#pragma unroll
            for (int m = 0; m < 4; ++m)
#pragma unroll
                for (int n = 0; n < 2; ++n) acc[a][b][m][n] = (f32x4){0.f, 0.f, 0.f, 0.f};
    bf16x8 At[4][2], B0[2][2], B1[2][2];
    const char* cA = (const char*)g.A + (size_t)cur.pm * tstep; const char* cB = (const char*)g.Bt + (size_t)cur.pn * tstep;
    S.a_ready(cur);
    if constexpr (SP2) {
        PG8_STAGE(PG8_SB(0, 0), cB, voffB); PG8_STAGE(PG8_SB(0, 1), cB + hstep, voffB); PG8_STAGE(PG8_SA(0, 0), cA, voffA); PG8_STAGE(PG8_SA(0, 1), cA + hstep, voffA);
        if (wr == 1) PG8_BAR;
        PG8_WAIT_V(2); PG8_BAR;
        PG8_STAGE(PG8_SB(1, 0), cB + kstep, voffB); PG8_STAGE(PG8_SA(1, 0), cA + kstep, voffA); PG8_STAGE(PG8_SB(1, 1), cB + hstep + kstep, voffB);
        PG8_WAIT_V(6); PG8_BAR;
    } else {
        PG8_STAGE(PG8_SB(0, 0), cB, voffB); PG8_STAGE(PG8_SA(0, 0), cA, voffA); PG8_STAGE(PG8_SB(0, 1), cB + hstep, voffB); PG8_STAGE(PG8_SA(0, 1), cA + hstep, voffA);
        if (wr == 1) PG8_BAR;
        PG8_WAIT_V(4); PG8_BAR;
        PG8_STAGE(PG8_SB(1, 0), cB + kstep, voffB); PG8_STAGE(PG8_SA(1, 0), cA + kstep, voffA); PG8_STAGE(PG8_SB(1, 1), cB + hstep + kstep, voffB);
        PG8_WAIT_V(6); PG8_BAR;
    }
    for (;;) {
        const bool has_next = S.next(ui + 1, nxt);
        const char* nA = has_next ? (const char*)g.A + (size_t)nxt.pm * tstep : cA; const char* nB = has_next ? (const char*)g.Bt + (size_t)nxt.pn * tstep : cB;
        for (int t = 0; t < nt; t += 2) {
            const bool last = (t == nt - 2);
            const char* a1 = cA + (size_t)(t + 1) * kstep;
            const char* a2 = last ? nA : cA + (size_t)(t + 2) * kstep; const char* b2 = last ? nB : cB + (size_t)(t + 2) * kstep;
            const char* a3 = a2 + kstep; const char* b3 = b2 + kstep;
            if (last && has_next) S.a_ready(nxt);
            if constexpr (SP2) {
            PG8_LDB(B0, 0, 0); PG8_LDB(B1, 0, 1); PG8_SCHED; PG8_LDA(At, 0, 0); PG8_STAGE(PG8_SA(1, 1), a1 + hstep, voffA);
            PG8_WAIT_V(8); PG8_WAIT_L(0); PG8_BAR; PG8_MMA(0, 0, At, B0); PG8_MMA(0, 1, At, B1); PG8_BAR; PG8_SCHED;
            PG8_LDA(At, 0, 1); PG8_STAGE(PG8_SB(0, 0), b2, voffB); PG8_STAGE(PG8_SB(0, 1), b2 + hstep, voffB); PG8_STAGE(PG8_SA(0, 0), a2, voffA);
            PG8_WAIT_V(8); PG8_WAIT_L(0); PG8_BAR; PG8_MMA(1, 0, At, B0); PG8_MMA(1, 1, At, B1); PG8_BAR; PG8_SCHED;
            PG8_LDB(B0, 1, 0); PG8_LDB(B1, 1, 1); PG8_SCHED; PG8_LDA(At, 1, 0); PG8_STAGE(PG8_SA(0, 1), a2 + hstep, voffA);
            PG8_WAIT_V(8); PG8_WAIT_L(0); PG8_BAR; PG8_MMA(0, 0, At, B0); PG8_MMA(0, 1, At, B1); PG8_BAR; PG8_SCHED;
            PG8_LDA(At, 1, 1); PG8_STAGE(PG8_SB(1, 0), b3, voffB); PG8_STAGE(PG8_SB(1, 1), b3 + hstep, voffB); PG8_STAGE(PG8_SA(1, 0), a3, voffA);
            PG8_WAIT_V(8); PG8_WAIT_L(0); PG8_BAR; PG8_MMA(1, 0, At, B0); PG8_MMA(1, 1, At, B1); PG8_BAR; PG8_SCHED;
            } else {
            PG8_LDB(B0, 0, 0); PG8_SCHED; PG8_LDA(At, 0, 0); PG8_STAGE(PG8_SA(1, 1), a1 + hstep, voffA);
            PG8_WAIT_L(8); PG8_BAR; PG8_WAIT_L(0); PG8_MMA(0, 0, At, B0); PG8_BAR; PG8_SCHED;
            PG8_LDB(B1, 0, 1); PG8_STAGE(PG8_SB(0, 0), b2, voffB);
            PG8_BAR; PG8_WAIT_L(0); PG8_MMA(0, 1, At, B1); PG8_BAR;
            PG8_LDA(At, 0, 1); PG8_STAGE(PG8_SA(0, 0), a2, voffA);
            PG8_BAR; PG8_WAIT_L(0); PG8_MMA(1, 0, At, B0); PG8_BAR; PG8_SCHED;
            PG8_STAGE(PG8_SB(0, 1), b2 + hstep, voffB);
            PG8_WAIT_V(6); PG8_BAR; PG8_MMA(1, 1, At, B1); PG8_BAR;
            PG8_LDB(B0, 1, 0); PG8_SCHED; PG8_LDA(At, 1, 0); PG8_STAGE(PG8_SA(0, 1), a2 + hstep, voffA);
            PG8_WAIT_L(8); PG8_BAR; PG8_WAIT_L(0); PG8_MMA(0, 0, At, B0); PG8_BAR; PG8_SCHED;
            PG8_LDB(B1, 1, 1); PG8_STAGE(PG8_SB(1, 0), b3, voffB);
            PG8_BAR; PG8_WAIT_L(0); PG8_MMA(0, 1, At, B1); PG8_BAR;
            PG8_LDA(At, 1, 1); PG8_STAGE(PG8_SA(1, 0), a3, voffA);
            PG8_BAR; PG8_WAIT_L(0); PG8_MMA(1, 0, At, B0); PG8_BAR; PG8_SCHED;
            PG8_STAGE(PG8_SB(1, 1), b3 + hstep, voffB);
            PG8_WAIT_V(6); PG8_BAR; PG8_MMA(1, 1, At, B1); PG8_BAR;
            }
        }
        if constexpr (ALIGN_EPI) { if (wr == 0) PG8_BAR; }
        if constexpr (!Epi::AFTER_DRAIN) { E(acc, cur, wr, wc, fr, fq); S.done(cur); }
        if (!has_next) break;
#pragma unroll
        for (int a = 0; a < 2; ++a)
#pragma unroll
            for (int b = 0; b < 2; ++b)
#pragma unroll
                for (int m = 0; m < 4; ++m)
#pragma unroll
                    for (int n = 0; n < 2; ++n) acc[a][b][m][n] = (f32x4){0.f, 0.f, 0.f, 0.f};
        cur = nxt; cA = nA; cB = nB; ++ui;
        if constexpr (ALIGN_EPI) { if (wr == 1) PG8_BAR; }
    }
    PG8_WAIT_V(0);
    if constexpr (!ALIGN_EPI) { if (wr == 0) PG8_BAR; }
    PG8_BAR;
    if constexpr (Epi::AFTER_DRAIN) { E.fused(acc, cur, wr, wc, fr, fq, lds, wid, lane); S.done(cur); }
#undef PG8_SA
#undef PG8_SB
#undef PG8_STAGE
#undef PG8_LDA
#undef PG8_LDB
#undef PG8_MMA
#undef PG8_WAIT_V
#undef PG8_WAIT_L
#undef PG8_BAR
#undef PG8_SCHED
}
}
#define GAS __attribute__((address_space(1)))
#define LAS __attribute__((address_space(3)))
typedef unsigned short bf16;
typedef unsigned v4u __attribute__((ext_vector_type(4)));
typedef float f32x4 __attribute__((ext_vector_type(4)));
typedef short bf16x8 __attribute__((ext_vector_type(8)));
typedef GAS unsigned gu32;
typedef GAS unsigned long long gu64;
#define RLX_AGENT __ATOMIC_RELAXED, __HIP_MEMORY_SCOPE_AGENT
#define LDS_WAIT() asm volatile("s_waitcnt lgkmcnt(0)" ::: "memory")
#define VM_WAIT() asm volatile("s_waitcnt vmcnt(0)" ::: "memory")
__device__ __forceinline__ unsigned long long rt() { return __builtin_amdgcn_s_memrealtime(); }
__device__ __forceinline__ unsigned f2bf(float f) { unsigned u = __builtin_bit_cast(unsigned, f); return (u + 0x7fffu + ((u >> 16) & 1u)) >> 16; }
typedef float f32x2_t __attribute__((ext_vector_type(2))); typedef __bf16 bf16x2_t __attribute__((ext_vector_type(2)));
__device__ __forceinline__ unsigned pk2(float lo, float hi) { const f32x2_t v = {lo, hi}; const bf16x2_t b = __builtin_convertvector(v, bf16x2_t); return __builtin_bit_cast(unsigned, b); }
#define XB_TMO      128
#define XB_XCNT(j)  (256  + 64 * (j))
#define XB_XSUB(j)  (1280 + 64 * (j))
#define XB_XGEN(j)  (2304 + 64 * (j))
#define XB_TOP      3328
#define XB_TOPGEN   3392
#define XCD_BAR_WORDS 3456
#define XB_SPIN_CAP (1u << 18)

__device__ __forceinline__ unsigned xb_ld(unsigned* p)              { return __hip_atomic_load(p, __ATOMIC_RELAXED, __HIP_MEMORY_SCOPE_AGENT); }
__device__ __forceinline__ unsigned xb_add(unsigned* p, unsigned v) { return __hip_atomic_fetch_add(p, v, __ATOMIC_RELAXED, __HIP_MEMORY_SCOPE_AGENT); }
__device__ __forceinline__ unsigned xb_xcc_id() { return (unsigned)__builtin_amdgcn_s_getreg((3 << 11) | 20) & 0xFu; }
#define XB_SPIN(cond, bar) do { unsigned _sp = 0; while (cond) { __builtin_amdgcn_s_sleep(1); \
    if ((++_sp & 255u) == 0u) { if (xb_ld(&(bar)[XB_TMO])) break; if (_sp > XB_SPIN_CAP) { atomicAdd(&(bar)[XB_TMO], 1u); break; } } } } while (0)

struct XcdBarrier {
    unsigned* bar; unsigned x;
    volatile LAS unsigned* st;
};

__device__ __forceinline__ XcdBarrier xcd_barrier_post(unsigned* bar, volatile LAS unsigned* st) {
    XcdBarrier b; b.bar = bar; b.x = xb_xcc_id(); b.st = st;
    if (threadIdx.x == 0) (void)xb_add(&bar[XB_XCNT(b.x)], 1u);
    return b;
}
__device__ __forceinline__ void xcd_barrier_complete(unsigned* bar, unsigned x, unsigned& nloc, unsigned& nx) {
    const unsigned G = gridDim.x * gridDim.y * gridDim.z;
    unsigned sum, cnt, mine, sp = 0u;
    for (;;) {
        sum = 0u; cnt = 0u; mine = 0u;
#pragma unroll
        for (unsigned j = 0; j < 16; ++j) { const unsigned c = xb_ld(&bar[XB_XCNT(j)]); sum += c; cnt += (c > 0u) ? 1u : 0u; mine = (j == x) ? c : mine; }
        if (sum == G) break;
        __builtin_amdgcn_s_sleep(1);
        if ((++sp & 255u) == 0u) { if (xb_ld(&bar[XB_TMO])) break; if (sp > XB_SPIN_CAP) { atomicAdd(&bar[XB_TMO], 1u); break; } }
    }
    nloc = mine > 0u ? mine : 1u; nx = cnt > 0u ? cnt : 1u;
}

__device__ __forceinline__ void xcd_barrier(const XcdBarrier& b) {
    asm volatile("s_waitcnt vmcnt(0)" ::: "memory");
    __syncthreads();
    if (threadIdx.x == 0) {
        unsigned* bar = b.bar;
        __builtin_amdgcn_s_waitcnt(0);
        unsigned nloc = b.st[0], nx = b.st[1];
        if (nloc == 0u) { xcd_barrier_complete(bar, b.x, nloc, nx); b.st[0] = nloc; b.st[1] = nx; }
        const unsigned old = xb_add(&bar[XB_XSUB(b.x)], 1u);
        const unsigned gen = old / nloc;
        if (old + 1u == (gen + 1u) * nloc) {
            __builtin_amdgcn_fence(__ATOMIC_RELEASE, "agent");
            asm volatile("s_waitcnt vmcnt(0)" ::: "memory");
            const unsigned og = xb_add(&bar[XB_TOP], 1u);
            const unsigned tg = og / nx;
            if (og + 1u == (tg + 1u) * nx) xb_add(&bar[XB_TOPGEN], 1u);
            else XB_SPIN(xb_ld(&bar[XB_TOPGEN]) == tg, bar);
            __builtin_amdgcn_fence(__ATOMIC_ACQUIRE, "agent");
            xb_add(&bar[XB_XGEN(b.x)], 1u);
            asm volatile("s_waitcnt vmcnt(0)" ::: "memory");
        } else {
            XB_SPIN(xb_ld(&bar[XB_XGEN(b.x)]) == gen, bar);
            __builtin_amdgcn_fence(__ATOMIC_ACQUIRE, "agent");
            asm volatile("s_waitcnt vmcnt(0)" ::: "memory");
        }
    }
    __syncthreads();
}
constexpr int NWAVES = 8, NTHR = 512;
#ifndef MK_ONE_LAUNCH
#define MK_ONE_LAUNCH 1
#endif
constexpr int NPHASE = 15;
constexpr int D = 4096, NCTX = 8192, NLAT = 4096, NTOK = 12288, INC = 19456, FFN = 11008, MODC = 24576;
constexpr int C_RQ = 0, C_RK = 2048, C_RV = 4096, C_RG = 6144, C_AQ = 8192, C_AK = 10240, C_AV = 10752, C_GR = 11264, C_GA = 15360;
constexpr float EPS = 1e-6f;
constexpr float LOG2E = 1.4426950408889634f;
constexpr float ATT_SCALE = 0.08838834764831845f * LOG2E;
constexpr size_t MiB = 1u << 20;
constexpr size_t WS_CTL = 0, CTL_ZERO_BYTES = MiB;
constexpr size_t WS_MODS = 512 * 1024  , WS_MPART = 2 * MiB, WS_WIN = 18 * MiB, WS_WBR = 170 * MiB, WS_WBA = 186 * MiB, WS_WOUT = 202 * MiB, WS_WUP = 234 * MiB, WS_WDN = 406 * MiB;
constexpr size_t WS_R1 = 492 * MiB, WS_R2 = 1008 * MiB, WS_R3 = 1200 * MiB, WS_END = 1392 * MiB;
constexpr size_t O_Y = 0, O_K = 50331648, O_V = 54525952, O_SF = 58720256, O_SB = 75497472, O_END = 92274688;
constexpr int CW_BAR = 4096;
constexpr int LDS_BYTES = 147456, LDSCTL_OFF = LDS_BYTES - 1024, MISC_OFF = LDSCTL_OFF + 320;

struct Frame {
    LAS unsigned char* lds;
    volatile LAS unsigned* MISC;
    gu32* ctl;
    int tid, lane, wave, vcu, G, flags;
    const float *xp, *xs, *cache_k, *cache_v, *st_f, *st_b, *c, *c_ctx, *w_mod, *b_mod, *n_mix_pre, *n_mix_post, *n_ffn_pre, *n_ffn_post;
    const float *w_in, *ld_f, *ld_b, *gn_w, *sink, *w_br, *w_ba, *w_out, *w_up, *w_dn;
    float* out;
    float *mods, *mpart;
    bf16 *Win_t, *Wbr_t, *Wba_t, *Wout_t, *Wup_t, *Wdn_t;
    bf16 *P, *H1, *RO, *AO, *T1, *T2, *MIX, *H2, *UA, *UB;
    float *OF, *OB; bf16 *MO, *X1, *FF;
    bf16 *VT, *CK, *CVT, *VTRC, *VTRL, *KT, *S0TF, *S0TB;
};

__device__ __forceinline__ float bf2f(unsigned short b) { return __uint_as_float((unsigned)b << 16); }
__device__ __forceinline__ float bflo(unsigned w) { return __uint_as_float(w << 16); }
__device__ __forceinline__ float bfhi(unsigned w) { return __uint_as_float(w & 0xffff0000u); }
__device__ __forceinline__ float wave_sum(float v) {
#pragma unroll
    for (int o = 1; o < 64; o <<= 1) v += __shfl_xor(v, o);
    return v;
}
__device__ __forceinline__ float wave_max(float v) {
#pragma unroll
    for (int o = 1; o < 64; o <<= 1) v = fmaxf(v, __shfl_xor(v, o));
    return v;
}
__device__ __forceinline__ float sigm_f(float x) { return __builtin_amdgcn_rcpf(1.f + __builtin_amdgcn_exp2f(-1.4426950408889634f * x)); }
__device__ __forceinline__ float silu_f(float x) { return x * sigm_f(x); }
__device__ __forceinline__ const float* xrow(const Frame& F, int r) { return r < NCTX ? F.xp + (size_t)r * D : F.xs + (size_t)(r - NCTX) * D; }
__device__ __forceinline__ int cond_of(int r) { return r < NCTX ? 0 : 1 + ((r - NCTX) >> 10); }

__device__ __forceinline__ void unpack8(const v4u a, float (&x)[8]) { x[0] = bflo(a.x); x[1] = bfhi(a.x); x[2] = bflo(a.y); x[3] = bfhi(a.y); x[4] = bflo(a.z); x[5] = bfhi(a.z); x[6] = bflo(a.w); x[7] = bfhi(a.w); }
__device__ __forceinline__ v4u pack8(const float (&x)[8]) { v4u o; o.x = pk2(x[0], x[1]); o.y = pk2(x[2], x[3]); o.z = pk2(x[4], x[5]); o.w = pk2(x[6], x[7]); return o; }
__device__ __forceinline__ void ph_mods_partial(Frame& F, int nb_lo, int nb_hi, int cidx, int ncu) {
    LAS float* sm = (LAS float*)(F.lds);
    const int nnb = nb_hi - nb_lo;
    for (int it = cidx; it < 64 * nnb; it += ncu) {
        const int ks = it / nnb, nb = nb_lo + it % nnb, k0 = ks * 64, n0 = nb * 2048 + F.tid * 4;
        if (F.tid < 320) { const int j = F.tid >> 6, kk = F.tid & 63; const float x = (j == 0) ? F.c_ctx[k0 + kk] : F.c[(j - 1) * D + k0 + kk]; sm[F.tid] = silu_f(x); }
        __syncthreads();
        f32x4 acc[5];
#pragma unroll
        for (int j = 0; j < 5; ++j) acc[j] = (ks == 0) ? *(const f32x4*)(F.b_mod + n0) : (f32x4){0.f, 0.f, 0.f, 0.f};
        const float* wp = F.w_mod + (size_t)k0 * MODC + n0;
#pragma unroll 1
        for (int k8 = 0; k8 < 64; k8 += 8) { f32x4 wv[8];
#pragma unroll
            for (int q = 0; q < 8; ++q) wv[q] = __builtin_nontemporal_load((const f32x4*)(wp + (size_t)(k8 + q) * MODC));
            __builtin_amdgcn_sched_barrier(0);
#pragma unroll
            for (int q = 0; q < 8; ++q)
#pragma unroll
                for (int j = 0; j < 5; ++j) acc[j] += sm[j * 64 + k8 + q] * wv[q]; }
        if (!(F.flags & 1))
#pragma unroll
        for (int j = 0; j < 5; ++j) { float* mp = F.mods + (size_t)j * MODC + n0;
            __hip_atomic_fetch_add(mp + 0, acc[j].x, __ATOMIC_RELAXED, __HIP_MEMORY_SCOPE_AGENT); __hip_atomic_fetch_add(mp + 1, acc[j].y, __ATOMIC_RELAXED, __HIP_MEMORY_SCOPE_AGENT);
            __hip_atomic_fetch_add(mp + 2, acc[j].z, __ATOMIC_RELAXED, __HIP_MEMORY_SCOPE_AGENT); __hip_atomic_fetch_add(mp + 3, acc[j].w, __ATOMIC_RELAXED, __HIP_MEMORY_SCOPE_AGENT); }
        __syncthreads();
    }
}
template <bool UPPERM> __device__ __forceinline__ void p0_transpose_item(const float* W, int K, int N, bf16* WT, int row_off, LAS float* scr, int item, int lane) {
    const int nblk = N / 32, kb = item / nblk, nb = item % nblk, k0 = 64 * kb, n0 = 32 * nb;
    const int d0 = UPPERM ? (n0 < FFN ? 256 * (n0 / 128) + (n0 % 128) : 256 * ((n0 - FFN) / 128) + 128 + ((n0 - FFN) % 128)) : n0;
    float tw[32];
#pragma unroll
    for (int i = 0; i < 32; ++i) tw[i] = __builtin_nontemporal_load(W + (size_t)(k0 + 2 * i + (lane >> 5)) * N + n0 + (lane & 31));
    __builtin_amdgcn_sched_barrier(0);
#pragma unroll
    for (int i = 0; i < 32; ++i) scr[(2 * i + (lane >> 5)) * 33 + (lane & 31)] = tw[i];
    LDS_WAIT(); asm volatile("" ::: "memory");
    const int c = lane & 7;
#pragma unroll
    for (int j = 0; j < 4; ++j) { const int n = (lane >> 3) + 8 * j; const LAS float* s = scr + (8 * c) * 33 + n;
        v4u o; o.x = pk2(s[0 * 33], s[1 * 33]); o.y = pk2(s[2 * 33], s[3 * 33]); o.z = pk2(s[4 * 33], s[5 * 33]); o.w = pk2(s[6 * 33], s[7 * 33]);
        *(GAS v4u*)(WT + (size_t)(row_off + d0 + n) * K + k0 + 8 * c) = o; }
    LDS_WAIT(); asm volatile("" ::: "memory");
}
template <bool UPPERM> __device__ __forceinline__ void p0_item4(const float* W, int K, int N, bf16* WT, LAS float* scr, int item, int lane) {
    const int nblk = N / 32, kg = item / nblk, nb = item - kg * nblk;
#pragma unroll 1
    for (int s = 0; s < 4; ++s) p0_transpose_item<UPPERM>(W, K, N, WT, 0, scr, (4 * kg + s) * nblk + nb, lane);
}
__device__ __forceinline__ void ph_convert(Frame& F, int part, int cidx, int ncu) {
    LAS float* scr = (LAS float*)(F.lds + 8192 + F.wave * 12288);
    const int gw = cidx * NWAVES + F.wave, NGW = ncu * NWAVES;
    constexpr int I_IN = (D / 256) * (INC / 32), I_BR = (2048 / 256) * (D / 32), I_OUT = (D / 256) * (D / 32), I_UP = (D / 256) * (2 * FFN / 32), I_DN = (FFN / 256) * (D / 32);
    if (part == 0) {
        for (int it = gw; it < I_IN + I_UP; it += NGW) {
            if (it < I_IN) p0_item4<false>(F.w_in, D, INC, F.Win_t, scr, it, F.lane);
            else p0_item4<true>(F.w_up, D, 2 * FFN, F.Wup_t, scr, it - I_IN, F.lane); }
    } else if (part == 1) {
        for (int it = gw; it < 2 * I_BR + I_OUT; it += NGW) {
            if (it < I_BR) p0_item4<false>(F.w_br, 2048, D, F.Wbr_t, scr, it, F.lane);
            else if (it < 2 * I_BR) p0_item4<false>(F.w_ba, 2048, D, F.Wba_t, scr, it - I_BR, F.lane);
            else p0_item4<false>(F.w_out, D, D, F.Wout_t, scr, it - 2 * I_BR, F.lane); }
    } else {
        for (int it = gw; it < I_DN; it += NGW) p0_item4<false>(F.w_dn, FFN, D, F.Wdn_t, scr, it, F.lane);
    }
}
__device__ __forceinline__ void ph_cache(Frame& F) {
    for (int idx = F.vcu * NTHR + F.tid; idx < 131072; idx += F.G * NTHR) {
        { const int d8 = idx & 15, j = (idx >> 4) & 511, kvh = (idx >> 13) & 3, b = idx >> 15;
          const float* sp = F.cache_k + ((size_t)(b * 512 + j) * 4 + kvh) * 128 + d8 * 8; const f32x4 a = *(const f32x4*)sp, c2 = *(const f32x4*)(sp + 4);
          v4u o; o.x = pk2(a.x, a.y); o.y = pk2(a.z, a.w); o.z = pk2(c2.x, c2.y); o.w = pk2(c2.z, c2.w);
          *(v4u*)(F.CK + ((size_t)(b * 4 + kvh) * 512 + j) * 128 + d8 * 8) = o; }
        { const int jj8 = idx & 7, d = (idx >> 3) & 127, jb = (idx >> 10) & 7, kvh = (idx >> 13) & 3, b = idx >> 15;
          float x[8];
#pragma unroll
          for (int e = 0; e < 8; ++e) x[e] = F.cache_v[((size_t)(b * 512 + jb * 64 + jj8 * 8 + e) * 4 + kvh) * 128 + d];
          *(v4u*)(F.CVT + (((size_t)(b * 4 + kvh) * 8 + jb) * 128 + d) * 64 + jj8 * 8) = pack8(x); }
    }
}
__device__ __forceinline__ void ph_s0t(Frame& F) {
    for (int idx = F.vcu * NTHR + F.tid; idx < 2 * 32 * 256 * 32; idx += F.G * NTHR) {
        const int k8 = idx & 31, dv = (idx >> 5) & 255, bh = (idx >> 13) & 31, dir = idx >> 18;
        const float* sp = (dir ? F.st_b : F.st_f) + ((size_t)bh * 256 + 8 * k8) * 256 + dv; float x[8];
#pragma unroll
        for (int e = 0; e < 8; ++e) x[e] = sp[(size_t)e * 256];
        *(v4u*)((dir ? F.S0TB : F.S0TF) + ((size_t)bh * 256 + dv) * 256 + 8 * k8) = pack8(x);
    }
}
__device__ __forceinline__ void ph_h1(Frame& F) {
    const int gw = F.vcu * NWAVES + F.wave, NGW = F.G * NWAVES;
    for (int r = gw; r < NTOK; r += NGW) {
        const f32x4* xr = (const f32x4*)xrow(F, r) + F.lane; f32x4 v[16]; float ss = 0.f;
#pragma unroll
        for (int j = 0; j < 16; ++j) v[j] = __builtin_nontemporal_load(xr + 64 * j);
#pragma unroll
        for (int j = 0; j < 16; ++j) ss += (v[j].x * v[j].x + v[j].y * v[j].y) + (v[j].z * v[j].z + v[j].w * v[j].w);
        const float rstd = rsqrtf(wave_sum(ss) * (1.f / D) + EPS);
        const float* md = F.mods + (size_t)cond_of(r) * MODC;
#pragma unroll
        for (int jb = 0; jb < 16; jb += 4) { f32x4 w[4], sh[4], sc[4];
#pragma unroll
            for (int q = 0; q < 4; ++q) { const int col = 4 * (F.lane + 64 * (jb + q)); w[q] = *(const f32x4*)(F.n_mix_pre + col); sh[q] = *(const f32x4*)(md + col); sc[q] = *(const f32x4*)(md + D + col); }
            __builtin_amdgcn_sched_barrier(0);
#pragma unroll
            for (int q = 0; q < 4; ++q) { const int col = 4 * (F.lane + 64 * (jb + q)); const f32x4 y = (v[jb + q] * rstd * w[q]) * (1.f + sc[q]) + sh[q];
                *(unsigned long long*)(F.H1 + (size_t)r * D + col) = (unsigned long long)pk2(y.x, y.y) | ((unsigned long long)pk2(y.z, y.w) << 32); }
            __builtin_amdgcn_sched_barrier(0); }
    }
}
__device__ __forceinline__ void scale_chunk(bf16* p, float s) { float x[8]; unpack8(*(const v4u*)p, x);
#pragma unroll
    for (int e = 0; e < 8; ++e) x[e] *= s;
    *(v4u*)p = pack8(x); }
template <int Q> __device__ __forceinline__ void rope_ld(const bf16* seg, int ch, v4u& a, v4u& b) { constexpr int CPG = Q / 8; const int g = ch / CPG, i0 = (ch % CPG) * 8; const bf16* p1 = seg + g * 2 * Q + i0; a = *(const v4u*)p1; b = *(const v4u*)(p1 + Q); }
template <int Q> __device__ __forceinline__ void rope_st(bf16* seg, int ch, const v4u a, const v4u b, float scale, float rowpos, float colpos) {
    constexpr int CPG = Q / 8; const int g = ch / CPG, i0 = (ch % CPG) * 8; bf16* p1 = seg + g * 2 * Q + i0; bf16* p2 = p1 + Q;
    const float pos = (g & 1) ? colpos : rowpos; float x1[8], x2[8], o1[8], o2[8]; unpack8(a, x1); unpack8(b, x2);
#pragma unroll
    for (int e = 0; e < 8; ++e) { const float f = __builtin_amdgcn_exp2f(-(float)(i0 + e) * (13.287712379549449f / Q)); const float ang = pos * f; const float s = __sinf(ang), c = __cosf(ang);
        o1[e] = (x1[e] * c - x2[e] * s) * scale; o2[e] = (x1[e] * s + x2[e] * c) * scale; }
    *(v4u*)p1 = pack8(o1); *(v4u*)p2 = pack8(o2);
}
__device__ __forceinline__ void ph_post(Frame& F) {
    const int gw = F.vcu * NWAVES + F.wave, NGW = F.G * NWAVES, lane = F.lane;
    for (int r = gw; r < NTOK; r += NGW) {
        bf16* pr = F.P + (size_t)r * INC;
        if (r < NCTX) {
            const v4u kv = *(const v4u*)(pr + C_AK + 8 * lane), vv = *(const v4u*)(pr + C_AV + 8 * lane);
            __builtin_amdgcn_sched_barrier(0);
            float x[8]; unpack8(kv, x);
            float* ko = F.out + O_K + (size_t)r * 512 + 8 * lane; *(f32x4*)ko = (f32x4){x[0], x[1], x[2], x[3]}; *(f32x4*)(ko + 4) = (f32x4){x[4], x[5], x[6], x[7]};
            unpack8(vv, x);
            float* vo = F.out + O_V + (size_t)r * 512 + 8 * lane; *(f32x4*)vo = (f32x4){x[0], x[1], x[2], x[3]}; *(f32x4*)(vo + 4) = (f32x4){x[4], x[5], x[6], x[7]};
        } else {
            const int t = (r - NCTX) & 1023; const float rowpos = (float)(t >> 6), colpos = (float)(t & 63);
            v4u a[7], b[7];
            rope_ld<64>(pr + C_RQ, lane, a[0], b[0]); rope_ld<64>(pr + C_RQ, lane + 64, a[1], b[1]);
            rope_ld<64>(pr + C_RK, lane, a[2], b[2]); rope_ld<64>(pr + C_RK, lane + 64, a[3], b[3]);
            rope_ld<32>(pr + C_AQ, lane, a[4], b[4]); rope_ld<32>(pr + C_AQ, lane + 64, a[5], b[5]);
            rope_ld<32>(pr + C_AK, lane & 31, a[6], b[6]);
            __builtin_amdgcn_sched_barrier(0);
            rope_st<64>(pr + C_RQ, lane, a[0], b[0], 1.f, rowpos, colpos); rope_st<64>(pr + C_RQ, lane + 64, a[1], b[1], 1.f, rowpos, colpos);
            rope_st<64>(pr + C_RK, lane, a[2], b[2], 1.f, rowpos, colpos); rope_st<64>(pr + C_RK, lane + 64, a[3], b[3], 1.f, rowpos, colpos);
            rope_st<32>(pr + C_AQ, lane, a[4], b[4], ATT_SCALE, rowpos, colpos); rope_st<32>(pr + C_AQ, lane + 64, a[5], b[5], ATT_SCALE, rowpos, colpos);
            if (lane < 32) rope_st<32>(pr + C_AK, lane, a[6], b[6], 1.f, rowpos, colpos);
        }
    }
}
template <bool SCALE> __device__ __forceinline__ void tr_tile(const bf16* srow, bf16* dst, size_t dstride, float scale, LAS unsigned char* scr, int lane) {
    v4u a[8];
#pragma unroll
    for (int c8 = 0; c8 < 8; ++c8) a[c8] = *(const v4u*)(srow + 8 * c8);
    __builtin_amdgcn_sched_barrier(0);
#pragma unroll
    for (int c8 = 0; c8 < 8; ++c8) { LAS unsigned short* d = (LAS unsigned short*)(scr + (8 * c8) * 144 + 2 * lane); unsigned w[4] = {a[c8].x, a[c8].y, a[c8].z, a[c8].w};
#pragma unroll
        for (int q = 0; q < 4; ++q) { unsigned lo = w[q] & 0xffffu, hi = w[q] >> 16;
            if (SCALE) { const unsigned p = pk2(bflo(w[q]) * scale, bfhi(w[q]) * scale); lo = p & 0xffffu; hi = p >> 16; }
            d[(2 * q) * 72] = (unsigned short)lo; d[(2 * q + 1) * 72] = (unsigned short)hi; } }
    LDS_WAIT(); asm volatile("" ::: "memory");
#pragma unroll
    for (int j = 0; j < 8; ++j) { const int f = (lane >> 3) + 8 * j; const v4u o = *(const LAS v4u*)(scr + f * 144 + 16 * (lane & 7)); *(v4u*)(dst + (size_t)f * dstride + 8 * (lane & 7)) = o; }
    LDS_WAIT(); asm volatile("" ::: "memory");
}
__device__ __forceinline__ void ph_transposes(Frame& F) {
    LAS unsigned char* scr = F.lds + F.wave * 9216;
    const int gw = F.vcu * NWAVES + F.wave, NGW = F.G * NWAVES, lane = F.lane;
    for (int it = gw; it < 15872; it += NGW) {
        if (it < 1536) { const int blk = it >> 3, kvh = (it >> 1) & 3, half = it & 1;
            tr_tile<false>(F.P + (size_t)(blk * 64 + lane) * INC + C_AV + kvh * 128 + 64 * half, F.VT + (size_t)(blk * 4 + kvh) * 8192 + (size_t)(64 * half) * 64, 64, 1.f, scr, lane);
        } else if (it < 7680) { const int i2 = it - 1536, blk = i2 >> 5, h = (i2 >> 2) & 7, q = i2 & 3, row0 = blk * 64;
            const bf16* srow = F.P + (size_t)(row0 + lane) * INC + C_RV + h * 256 + 64 * q;
            if (row0 < NCTX) { const int b = row0 >> 8, t0 = row0 & 255; tr_tile<false>(srow, F.VTRC + ((size_t)(b * 8 + h) * 256 + 64 * q) * 256 + t0, 256, 1.f, scr, lane); }
            else { const int rl = row0 - NCTX, b = rl >> 10, t0 = rl & 1023; tr_tile<false>(srow, F.VTRL + ((size_t)(b * 8 + h) * 256 + 64 * q) * 1024 + t0, 1024, 1.f, scr, lane); }
        } else { const int i2 = it - 7680, blk = i2 >> 6, h = (i2 >> 3) & 7, q = (i2 >> 1) & 3, dir = i2 & 1, row0 = blk * 64, b = row0 >> 8, t0 = row0 & 255, t = t0 + lane;
            const float lg2 = -__expf((dir ? F.ld_b : F.ld_f)[h]) * LOG2E;
            const float sc = __builtin_amdgcn_exp2f((float)(dir ? t : 255 - t) * lg2) * 0.0625f;
            tr_tile<true>(F.P + (size_t)(row0 + lane) * INC + C_RK + h * 256 + 64 * q, F.KT + ((size_t)((b * 8 + h) * 2 + dir) * 256 + 64 * q) * 256 + t0, 256, sc, scr, lane);
        }
    }
}
#define WG_BAR() do { asm volatile("s_waitcnt lgkmcnt(0)" ::: "memory"); __builtin_amdgcn_s_barrier(); asm volatile("" ::: "memory"); } while (0)
typedef float f32x16 __attribute__((ext_vector_type(16)));
constexpr int AT_KROW = 272, AT_VROW = 136, AT_KBYTES = 64 * AT_KROW, AT_BUF = AT_KBYTES + 128 * AT_VROW;
struct AtTile { const bf16* k; int kstride; const bf16* vt; int kpos0; bool masked; };
__device__ __forceinline__ void at_gload(const AtTile& T, int tid, v4u (&kr)[2], v4u (&vr)[2]) {
    const unsigned ko = (unsigned)(tid >> 4) * (unsigned)T.kstride * 2u + (unsigned)(tid & 15) * 16u, ks = 32u * (unsigned)T.kstride * 2u, vo = (unsigned)tid * 16u;
    const char* kp = (const char*)T.k; const char* vp = (const char*)T.vt;
#pragma unroll
    for (int i = 0; i < 2; ++i) { kr[i] = *(const v4u*)(kp + (ko + i * ks)); vr[i] = *(const v4u*)(vp + (vo + i * 8192u)); }
}
__device__ __forceinline__ void at_lstore(LAS unsigned char* buf, int tid, const v4u (&kr)[2], const v4u (&vr)[2]) {
    LAS unsigned char* kd = buf + (tid >> 4) * AT_KROW + (tid & 15) * 16; LAS unsigned char* vd = buf + AT_KBYTES + (tid >> 3) * AT_VROW + (tid & 7) * 16;
#pragma unroll
    for (int i = 0; i < 2; ++i) {
        *(LAS v4u*)(kd + i * 32 * AT_KROW) = kr[i];
        LAS unsigned long long* vp = (LAS unsigned long long*)(vd + i * 64 * AT_VROW);
        vp[0] = (unsigned long long)vr[i].x | ((unsigned long long)vr[i].y << 32); vp[1] = (unsigned long long)vr[i].z | ((unsigned long long)vr[i].w << 32); }
}
__device__ __forceinline__ AtTile at_tile(const Frame& F, int kind, int b, int kvh, int t0, int nwin, int i0, int i) {
    AtTile T;
    if (kind == 0) { const int row = b * 256 + 64 * i; T.k = F.P + (size_t)row * INC + C_AK + kvh * 128; T.kstride = INC; T.vt = F.VT + ((size_t)(row >> 6) * 4 + kvh) * 8192; T.kpos0 = 0; T.masked = false; }
    else if (i < nwin) { const int ks = t0 - 128 + 64 * (i0 + i); const int row = NCTX + b * 1024 + ks; T.k = F.P + (size_t)row * INC + C_AK + kvh * 128; T.kstride = INC; T.vt = F.VT + ((size_t)(row >> 6) * 4 + kvh) * 8192; T.kpos0 = ks; T.masked = true; }
    else { const int j = i - nwin; T.k = F.CK + ((size_t)(b * 4 + kvh) * 512 + 64 * j) * 128; T.kstride = 128; T.vt = F.CVT + ((size_t)(b * 4 + kvh) * 8 + j) * 8192; T.kpos0 = 0; T.masked = false; }
    return T;
}
__device__ __forceinline__ void at_unit(Frame& F, int kind, int b, int kvh, int tb) {
    const int tid = F.tid, lane = F.lane, r = lane & 31, hi = lane >> 5, g = F.wave & 3, sub = F.wave >> 2, h = kvh * 4 + g;
    const int t0 = tb * 64;
    int nt, nwin = 0, i0 = 0;
    if (kind == 0) nt = 4; else { i0 = t0 >= 128 ? 0 : (128 - t0) / 64; const int il = (1088 - t0) / 64 > 4 ? 4 : (1088 - t0) / 64; nwin = il - i0 + 1; nt = nwin + 8; }
    const int rowbase = (kind == 0 ? b * 256 : NCTX + b * 1024) + t0 + 32 * sub;
    const int tq = t0 + 32 * sub + r;
    bf16x8 qf[8];
    { const bf16* qp = F.P + (size_t)(rowbase + r) * INC + C_AQ + h * 128 + 8 * hi;
#pragma unroll
      for (int ds = 0; ds < 8; ++ds) qf[ds] = *(const bf16x8*)(qp + 16 * ds); }
    __builtin_amdgcn_sched_barrier(0);
    if (kind == 0) {
#pragma unroll
        for (int ds = 0; ds < 8; ++ds) { const v4u w = __builtin_bit_cast(v4u, qf[ds]); v4u o;
            o.x = pk2(bflo(w.x) * ATT_SCALE, bfhi(w.x) * ATT_SCALE); o.y = pk2(bflo(w.y) * ATT_SCALE, bfhi(w.y) * ATT_SCALE); o.z = pk2(bflo(w.z) * ATT_SCALE, bfhi(w.z) * ATT_SCALE); o.w = pk2(bflo(w.w) * ATT_SCALE, bfhi(w.w) * ATT_SCALE);
            qf[ds] = __builtin_bit_cast(bf16x8, o); }
    }
    float m = F.sink[h] * LOG2E, l = hi ? 0.f : 1.f;
    f32x16 o[4];
#pragma unroll
    for (int db = 0; db < 4; ++db)
#pragma unroll
        for (int e = 0; e < 16; ++e) o[db][e] = 0.f;
    v4u kr[2], vr[2];
    { const AtTile T = at_tile(F, kind, b, kvh, t0, nwin, i0, 0); at_gload(T, tid, kr, vr); at_lstore(F.lds, tid, kr, vr); }
    __syncthreads();
    unsigned touch_prev = 0u;
#pragma unroll 1
    for (int i = 0; i < nt; ++i) {
        asm volatile("" :: "v"(touch_prev));
        LAS unsigned char* buf = F.lds + (i & 1) * AT_BUF;
        const AtTile T = at_tile(F, kind, b, kvh, t0, nwin, i0, i);
        if (i + 1 < nt) { const AtTile Tn = at_tile(F, kind, b, kvh, t0, nwin, i0, i + 1); at_gload(Tn, tid, kr, vr); }
        const AtTile T2 = at_tile(F, kind, b, kvh, t0, nwin, i0, (i + 2 < nt) ? i + 2 : nt - 1);
        const unsigned touch = *(const unsigned*)(T2.k + (size_t)((tid >> 1) & 63) * T2.kstride + (tid & 1) * 64);
        f32x16 s[2];
#pragma unroll
        for (int kb = 0; kb < 2; ++kb) {
#pragma unroll
            for (int e = 0; e < 16; ++e) s[kb][e] = 0.f;
#pragma unroll
            for (int ds = 0; ds < 8; ++ds) { const bf16x8 a = *(const LAS bf16x8*)(buf + (32 * kb + r) * AT_KROW + 32 * ds + 16 * hi); s[kb] = __builtin_amdgcn_mfma_f32_32x32x16_bf16(a, qf[ds], s[kb], 0, 0, 0); }
        }
        if (T.masked) {
#pragma unroll
            for (int kb = 0; kb < 2; ++kb)
#pragma unroll
                for (int e = 0; e < 16; ++e) { const int kpos = T.kpos0 + 32 * kb + (e & 3) + 8 * (e >> 2) + 4 * hi; const int dlt = kpos - tq; if (dlt > 128 || dlt < -128) s[kb][e] = -1e30f; }
        }
        float tmax = s[0][0];
#pragma unroll
        for (int kb = 0; kb < 2; ++kb)
#pragma unroll
            for (int e = 0; e < 16; ++e) tmax = fmaxf(tmax, s[kb][e]);
        tmax = fmaxf(tmax, __shfl_xor(tmax, 32));
        const float mn = fmaxf(m, tmax), alpha = __builtin_amdgcn_exp2f(m - mn); m = mn;
        float ls = 0.f;
#pragma unroll
        for (int kb = 0; kb < 2; ++kb)
#pragma unroll
            for (int e = 0; e < 16; ++e) { const float p = __builtin_amdgcn_exp2f(s[kb][e] - mn); s[kb][e] = p; ls += p; }
        l = l * alpha + ls;
#pragma unroll
        for (int db = 0; db < 4; ++db)
#pragma unroll
            for (int e = 0; e < 16; ++e) o[db][e] *= alpha;
        bf16x8 pf[2][2];
#pragma unroll
        for (int kb = 0; kb < 2; ++kb)
#pragma unroll
            for (int sp = 0; sp < 2; ++sp) { v4u w; w.x = pk2(s[kb][8 * sp + 0], s[kb][8 * sp + 1]); w.y = pk2(s[kb][8 * sp + 2], s[kb][8 * sp + 3]); w.z = pk2(s[kb][8 * sp + 4], s[kb][8 * sp + 5]); w.w = pk2(s[kb][8 * sp + 6], s[kb][8 * sp + 7]); pf[kb][sp] = __builtin_bit_cast(bf16x8, w); }
#pragma unroll
        for (int db = 0; db < 4; ++db)
#pragma unroll
            for (int kb = 0; kb < 2; ++kb)
#pragma unroll
                for (int sp = 0; sp < 2; ++sp) { const LAS unsigned long long* vp = (const LAS unsigned long long*)(buf + AT_KBYTES + (32 * db + r) * AT_VROW + 64 * kb + 32 * sp + 8 * hi);
                    const unsigned long long a0 = vp[0], a1 = vp[2]; v4u w; w.x = (unsigned)a0; w.y = (unsigned)(a0 >> 32); w.z = (unsigned)a1; w.w = (unsigned)(a1 >> 32);
                    o[db] = __builtin_amdgcn_mfma_f32_32x32x16_bf16(__builtin_bit_cast(bf16x8, w), pf[kb][sp], o[db], 0, 0, 0); }
        touch_prev = touch;
        if (i + 1 < nt) at_lstore(F.lds + ((i + 1) & 1) * AT_BUF, tid, kr, vr);
        WG_BAR();
    }
    l += __shfl_xor(l, 32);
    const float inv = 1.f / l;
    bf16* op = F.AO + (size_t)(rowbase + r) * 2048 + h * 128 + 8 * hi;
#pragma unroll
    for (int db = 0; db < 4; ++db)
#pragma unroll
        for (int gq = 0; gq < 4; gq += 2) {
            unsigned ax = pk2(o[db][4 * gq] * inv, o[db][4 * gq + 1] * inv), ay = pk2(o[db][4 * gq + 2] * inv, o[db][4 * gq + 3] * inv);
            unsigned bx = pk2(o[db][4 * gq + 4] * inv, o[db][4 * gq + 5] * inv), by = pk2(o[db][4 * gq + 6] * inv, o[db][4 * gq + 7] * inv);
            { const auto rr = __builtin_amdgcn_permlane32_swap(ax, bx, false, false); ax = rr[0]; bx = rr[1]; }
            { const auto rr = __builtin_amdgcn_permlane32_swap(ay, by, false, false); ay = rr[0]; by = rr[1]; }
            v4u w; w.x = ax; w.y = ay; w.z = bx; w.w = by;
            *(v4u*)(op + 32 * db + 8 * gq) = w; }
}
__device__ __forceinline__ void ph_attention(Frame& F) {
    const int c = (F.G == 256) ? ((F.vcu & 7) * 32 + (F.vcu >> 3)) : F.vcu;
    if (c < 256) {
        at_unit(F, 1, c >> 6, (c >> 4) & 3, c & 15);
        for (int u = 2 * c; u < 2 * c + 2; ++u) at_unit(F, 0, u >> 4, (u >> 2) & 3, u & 3);
    }
}
constexpr int RT_KROW = 528, RT_VROW = 136, RT_KBYTES = 64 * RT_KROW, RT_BUF = RT_KBYTES + 256 * RT_VROW;
__device__ __forceinline__ void rt_gload(const bf16* kp, const bf16* vtp, int L, int tid, v4u (&kr)[4], v4u (&vr)[4]) {
    const unsigned ko = (unsigned)(tid >> 5) * (unsigned)(INC * 2) + (unsigned)(tid & 31) * 16u, vo = (unsigned)(tid >> 3) * (unsigned)L * 2u + (unsigned)(tid & 7) * 16u, vs = 64u * (unsigned)L * 2u;
    const char* kc = (const char*)kp; const char* vc = (const char*)vtp;
#pragma unroll
    for (int i = 0; i < 4; ++i) { kr[i] = *(const v4u*)(kc + (ko + i * (16u * INC * 2u))); vr[i] = *(const v4u*)(vc + (vo + i * vs)); }
}
__device__ __forceinline__ void rt_lstore(LAS unsigned char* buf, int tid, const v4u (&kr)[4], const v4u (&vr)[4]) {
    LAS unsigned char* kd = buf + (tid >> 5) * RT_KROW + (tid & 31) * 16; LAS unsigned char* vd = buf + RT_KBYTES + (tid >> 3) * RT_VROW + (tid & 7) * 16;
#pragma unroll
    for (int i = 0; i < 4; ++i) {
        *(LAS v4u*)(kd + i * 16 * RT_KROW) = kr[i];
        LAS unsigned long long* vp = (LAS unsigned long long*)(vd + i * 64 * RT_VROW);
        vp[0] = (unsigned long long)vr[i].x | ((unsigned long long)vr[i].y << 32); vp[1] = (unsigned long long)vr[i].z | ((unsigned long long)vr[i].w << 32); }
}
constexpr int RT_QBYTES = 128 * RT_KROW;
__device__ __forceinline__ void rt_unit(Frame& F, int kind, int b, int h, int qb) {
    const int tid = F.tid, lane = F.lane, r = lane & 31, hi = lane >> 5, qs = F.wave & 3, vh = F.wave >> 2;
    const int L = kind ? 1024 : 256, nt = L / 64;
    const int seq0 = kind ? NCTX + b * 1024 : b * 256;
    const int qi = qb * 128 + 32 * qs + r;
    const bf16* kbase = F.P + (size_t)seq0 * INC + C_RK + h * 256;
    const bf16* vtbase = (kind ? F.VTRL + (size_t)(b * 8 + h) * 256 * 1024 : F.VTRC + (size_t)(b * 8 + h) * 256 * 256);
    const float lf2 = -__expf(F.ld_f[h]) * 1.4426950408889634f, lb2 = -__expf(F.ld_b[h]) * 1.4426950408889634f;
    LAS unsigned char* buf = F.lds + RT_QBYTES;
    LAS float* tbl = (LAS float*)(F.lds + RT_QBYTES + RT_BUF);
    const int idiag = (qb * 128 + 32 * qs) >> 6;
    if (tid < 128) { const int dir = tid >> 6, th = (tid >> 5) & 1, ix = tid & 31, koff = 32 * (ix >> 4) + (ix & 3) + 8 * ((ix & 15) >> 2) + 4 * th;
        tbl[tid] = (dir ? __builtin_amdgcn_exp2f((float)koff * lb2) : __builtin_amdgcn_exp2f((float)(63 - koff) * lf2)) * 0.0625f; }
    const LAS unsigned char* qrow = F.lds + (32 * qs + r) * RT_KROW + 16 * hi;
    { const char* qp = (const char*)(F.P + (size_t)(seq0 + qb * 128) * INC + C_RQ + h * 256); const unsigned qo = (unsigned)(tid >> 5) * (unsigned)(INC * 2) + (unsigned)(tid & 31) * 16u;
      LAS unsigned char* qd = F.lds + (tid >> 5) * RT_KROW + (tid & 31) * 16;
      v4u qv[8];
#pragma unroll
      for (int i = 0; i < 8; ++i) qv[i] = *(const v4u*)(qp + (qo + i * (16u * INC * 2u)));
      __builtin_amdgcn_sched_barrier(0);
#pragma unroll
      for (int i = 0; i < 8; ++i) *(LAS v4u*)(qd + i * 16 * RT_KROW) = qv[i]; }
    f32x16 o[4];
#pragma unroll
    for (int db = 0; db < 4; ++db)
#pragma unroll
        for (int e = 0; e < 16; ++e) o[db][e] = 0.f;
    v4u kr[4], vr[4];
    rt_gload(kbase, vtbase, L, tid, kr, vr); rt_lstore(buf, tid, kr, vr);
    __syncthreads();
    unsigned touch_prev = 0u;
#pragma unroll 1
    for (int i = 0; i < nt; ++i) {
        asm volatile("" :: "v"(touch_prev));
        if (i + 1 < nt) rt_gload(kbase + (size_t)(64 * (i + 1)) * INC, vtbase + 64 * (i + 1), L, tid, kr, vr);
        const int it2 = (i + 2 < nt) ? i + 2 : nt - 1;
        const unsigned touch = *(const unsigned*)((const char*)(kbase + (size_t)(64 * it2 + ((tid >> 2) & 63)) * INC) + (tid & 3) * 128);
        bf16x8 pf[2][2];
        const bool below = i < idiag;
        const float afac = below ? __builtin_amdgcn_exp2f((float)(qi - (64 * i + 63)) * lf2) : __builtin_amdgcn_exp2f((float)(64 * i - qi) * lb2);
        const LAS f32x4* tp = (const LAS f32x4*)(tbl + (below ? 0 : 64) + 32 * hi);
#pragma unroll
        for (int kb = 0; kb < 2; ++kb) {
            f32x16 s;
#pragma unroll
            for (int e = 0; e < 16; ++e) s[e] = 0.f;
#pragma unroll
            for (int ds = 0; ds < 16; ++ds) { const bf16x8 q = *(const LAS bf16x8*)(qrow + 32 * ds); const bf16x8 a = *(const LAS bf16x8*)(buf + (32 * kb + r) * RT_KROW + 32 * ds + 16 * hi);
                s = __builtin_amdgcn_mfma_f32_32x32x16_bf16(a, q, s, 0, 0, 0); }
            if (i == idiag) {
#pragma unroll
                for (int e = 0; e < 16; ++e) { const int kj = 64 * i + 32 * kb + (e & 3) + 8 * (e >> 2) + 4 * hi; const int d = qi - kj;
                    const float ex = d > 0 ? (float)d * lf2 : (float)(-d) * lb2; float w = __builtin_amdgcn_exp2f(ex) * 0.0625f; if (d == 0) w = 0.125f;
                    s[e] *= w; }
            } else {
#pragma unroll
                for (int e4 = 0; e4 < 4; ++e4) { const f32x4 t4 = tp[kb * 4 + e4];
                    s[4 * e4 + 0] *= afac * t4.x; s[4 * e4 + 1] *= afac * t4.y; s[4 * e4 + 2] *= afac * t4.z; s[4 * e4 + 3] *= afac * t4.w; }
            }
#pragma unroll
            for (int sp = 0; sp < 2; ++sp) { v4u w; w.x = pk2(s[8 * sp + 0], s[8 * sp + 1]); w.y = pk2(s[8 * sp + 2], s[8 * sp + 3]); w.z = pk2(s[8 * sp + 4], s[8 * sp + 5]); w.w = pk2(s[8 * sp + 6], s[8 * sp + 7]); pf[kb][sp] = __builtin_bit_cast(bf16x8, w); }
            __builtin_amdgcn_sched_barrier(0);
        }
#pragma unroll
        for (int db = 0; db < 4; ++db)
#pragma unroll
            for (int kb = 0; kb < 2; ++kb)
#pragma unroll
                for (int sp = 0; sp < 2; ++sp) { const LAS unsigned long long* vp = (const LAS unsigned long long*)(buf + RT_KBYTES + (128 * vh + 32 * db + r) * RT_VROW + 64 * kb + 32 * sp + 8 * hi);
                    const unsigned long long a0 = vp[0], a1 = vp[2]; v4u w; w.x = (unsigned)a0; w.y = (unsigned)(a0 >> 32); w.z = (unsigned)a1; w.w = (unsigned)(a1 >> 32);
                    o[db] = __builtin_amdgcn_mfma_f32_32x32x16_bf16(__builtin_bit_cast(bf16x8, w), pf[kb][sp], o[db], 0, 0, 0); if (kb == 1 && sp == 1) __builtin_amdgcn_sched_barrier(0); }
        touch_prev = touch;
        WG_BAR();
        if (i + 1 < nt) { rt_lstore(buf, tid, kr, vr); WG_BAR(); }
    }
    int oz = 0; asm volatile("" : "+v"(oz));
    if (kind) {
        const float cf = __builtin_amdgcn_exp2f((float)(qi + 1) * lf2), cb = __builtin_amdgcn_exp2f((float)(L - qi) * lb2);
#pragma unroll
        for (int dir = 0; dir < 2; ++dir) { const bf16* sp0 = (dir ? F.S0TB : F.S0TF) + ((size_t)(b * 8 + h) * 256 + 128 * vh + r + oz) * 256 + 8 * hi; const float cc = dir ? cb : cf;
#pragma unroll
            for (int db = 0; db < 4; ++db) { f32x16 acc; bf16x8 af[16];
#pragma unroll
                for (int ds = 0; ds < 16; ++ds) af[ds] = *(const bf16x8*)(sp0 + (size_t)(32 * db) * 256 + 16 * ds);
                __builtin_amdgcn_sched_barrier(0);
#pragma unroll
                for (int e = 0; e < 16; ++e) acc[e] = 0.f;
#pragma unroll
                for (int ds = 0; ds < 16; ++ds) { const bf16x8 q = *(const LAS bf16x8*)(qrow + 32 * ds); acc = __builtin_amdgcn_mfma_f32_32x32x16_bf16(af[ds], q, acc, 0, 0, 0); }
#pragma unroll
                for (int e = 0; e < 16; ++e) o[db][e] += cc * acc[e];
                __builtin_amdgcn_sched_barrier(0); } }
    }
    const int row = seq0 + qi + oz;
    const bf16* gp = F.P + (size_t)row * INC + C_RG + h * 256 + 128 * vh + 4 * hi;
    unsigned long long g2v[16];
#pragma unroll
    for (int db = 0; db < 4; ++db)
#pragma unroll
        for (int gq = 0; gq < 4; ++gq) g2v[db * 4 + gq] = *(const unsigned long long*)(gp + 32 * db + 8 * gq);
    const float* gwp0 = F.gn_w + h * 256 + 128 * vh + 4 * hi + oz; f32x4 gwv[16];
#pragma unroll
    for (int k = 0; k < 16; ++k) gwv[k] = *(const f32x4*)(gwp0 + 8 * k);
    __builtin_amdgcn_sched_barrier(0);
    float ss = 0.f;
#pragma unroll
    for (int db = 0; db < 4; ++db)
#pragma unroll
        for (int e = 0; e < 16; ++e) ss += o[db][e] * o[db][e];
    ss += __shfl_xor(ss, 32);
    LAS float* red = (LAS float*)buf;
    if (hi == 0) red[(vh * 4 + qs) * 32 + r] = ss;
    __syncthreads();
    const float tot = red[qs * 32 + r] + red[(4 + qs) * 32 + r];
    const float rstd = rsqrtf(tot * (1.f / 256.f) + EPS);
    const float* gwp = F.gn_w + h * 256 + 128 * vh + 4 * hi;
    bf16* op = F.RO + (size_t)row * 2048 + h * 256 + 128 * vh + 8 * hi;
#pragma unroll
    for (int db = 0; db < 4; ++db)
#pragma unroll
        for (int gq = 0; gq < 4; gq += 2) { unsigned pkd[2][2];
#pragma unroll
            for (int t = 0; t < 2; ++t) { const int g = gq + t, dc = 32 * db + 8 * g;
                const unsigned long long g2 = g2v[db * 4 + g]; const unsigned g_lo = (unsigned)g2, g_hi = (unsigned)(g2 >> 32);
                const f32x4 gw4 = gwv[db * 4 + g];
                const float y0 = silu_f(bflo(g_lo)) * (o[db][4 * g] * rstd * gw4.x), y1 = silu_f(bfhi(g_lo)) * (o[db][4 * g + 1] * rstd * gw4.y), y2 = silu_f(bflo(g_hi)) * (o[db][4 * g + 2] * rstd * gw4.z), y3 = silu_f(bfhi(g_hi)) * (o[db][4 * g + 3] * rstd * gw4.w);
                pkd[t][0] = pk2(y0, y1); pkd[t][1] = pk2(y2, y3); }
            { const auto rr = __builtin_amdgcn_permlane32_swap(pkd[0][0], pkd[1][0], false, false); pkd[0][0] = rr[0]; pkd[1][0] = rr[1]; }
            { const auto rr = __builtin_amdgcn_permlane32_swap(pkd[0][1], pkd[1][1], false, false); pkd[0][1] = rr[0]; pkd[1][1] = rr[1]; }
            v4u w; w.x = pkd[0][0]; w.y = pkd[0][1]; w.z = pkd[1][0]; w.w = pkd[1][1];
            *(v4u*)(op + 32 * db + 8 * gq) = w; }
    __syncthreads();
}
__device__ __forceinline__ void ph_retention(Frame& F) {
    const int c = (F.G == 256) ? ((F.vcu & 7) * 32 + (F.vcu >> 3)) : F.vcu;
    if (c < 256) {
        rt_unit(F, 1, c >> 6, (c >> 3) & 7, c & 7);
        for (int u = 2 * c; u < 2 * c + 2; ++u) rt_unit(F, 0, u >> 4, (u >> 1) & 7, u & 1);
    }
}
__device__ __forceinline__ void ph_mix(Frame& F) {
    const size_t total = (size_t)NTOK * (D / 8);
    for (size_t i = (size_t)F.vcu * NTHR + F.tid; i < total; i += (size_t)F.G * NTHR) {
        const int r = (int)(i / (D / 8)), c8 = (int)(i % (D / 8)) * 8;
        float t1[8], t2[8], gr[8], ga[8], o[8];
        unpack8(*(const v4u*)(F.T1 + (size_t)r * D + c8), t1); unpack8(*(const v4u*)(F.T2 + (size_t)r * D + c8), t2);
        unpack8(*(const v4u*)(F.P + (size_t)r * INC + C_GR + c8), gr); unpack8(*(const v4u*)(F.P + (size_t)r * INC + C_GA + c8), ga);
#pragma unroll
        for (int e = 0; e < 8; ++e) o[e] = sigm_f(gr[e]) * t1[e] + sigm_f(ga[e]) * t2[e];
        *(v4u*)(F.MIX + (size_t)r * D + c8) = pack8(o);
    }
}
__device__ __forceinline__ f32x4 ld4bf(const bf16* p) { const unsigned long long w = *(const unsigned long long*)p; const unsigned lo = (unsigned)w, hi = (unsigned)(w >> 32); return (f32x4){bflo(lo), bfhi(lo), bflo(hi), bfhi(hi)}; }
__device__ __forceinline__ void st4bf(bf16* p, const f32x4 y) { *(unsigned long long*)p = (unsigned long long)pk2(y.x, y.y) | ((unsigned long long)pk2(y.z, y.w) << 32); }
__device__ __forceinline__ void ph_rowA(Frame& F) {
    const int gw = F.vcu * NWAVES + F.wave, NGW = F.G * NWAVES, lane = F.lane;
    for (int r = gw; r < NTOK; r += NGW) {
        const bf16* mo = F.MO + (size_t)r * D + 4 * lane; const f32x4* xr = (const f32x4*)xrow(F, r) + lane;
        const float* md = F.mods + (size_t)cond_of(r) * MODC;
        f32x4 v[16], xv[16]; float ss = 0.f;
#pragma unroll
        for (int j = 0; j < 16; ++j) { v[j] = ld4bf(mo + 256 * j); xv[j] = xr[64 * j]; }
#pragma unroll
        for (int j = 0; j < 16; ++j) ss += (v[j].x * v[j].x + v[j].y * v[j].y) + (v[j].z * v[j].z + v[j].w * v[j].w);
        const float rstd1 = rsqrtf(wave_sum(ss) * (1.f / D) + EPS);
        float ss2 = 0.f;
#pragma unroll
        for (int jb = 0; jb < 16; jb += 4) { f32x4 w[4], g[4];
#pragma unroll
            for (int q = 0; q < 4; ++q) { const int col = 4 * (lane + 64 * (jb + q)); w[q] = *(const f32x4*)(F.n_mix_post + col); g[q] = *(const f32x4*)(md + 2 * D + col); }
            __builtin_amdgcn_sched_barrier(0);
#pragma unroll
            for (int q = 0; q < 4; ++q) { const int j = jb + q, col = 4 * (lane + 64 * j);
                v[j] = xv[j] + g[q] * (v[j] * rstd1 * w[q]); ss2 += (v[j].x * v[j].x + v[j].y * v[j].y) + (v[j].z * v[j].z + v[j].w * v[j].w);
                st4bf(F.X1 + (size_t)r * D + col, v[j]); }
            __builtin_amdgcn_sched_barrier(0); }
        const float rstd2 = rsqrtf(wave_sum(ss2) * (1.f / D) + EPS);
#pragma unroll
        for (int jb = 0; jb < 16; jb += 4) { f32x4 w[4], sh[4], sc[4];
#pragma unroll
            for (int q = 0; q < 4; ++q) { const int col = 4 * (lane + 64 * (jb + q)); w[q] = *(const f32x4*)(F.n_ffn_pre + col); sh[q] = *(const f32x4*)(md + 3 * D + col); sc[q] = *(const f32x4*)(md + 4 * D + col); }
            __builtin_amdgcn_sched_barrier(0);
#pragma unroll
            for (int q = 0; q < 4; ++q) { const int col = 4 * (lane + 64 * (jb + q)); st4bf(F.H2 + (size_t)r * D + col, (v[jb + q] * rstd2 * w[q]) * (1.f + sc[q]) + sh[q]); }
            __builtin_amdgcn_sched_barrier(0); }
    }
}
__device__ __forceinline__ void ph_rowB(Frame& F) {
    const int gw = F.vcu * NWAVES + F.wave, NGW = F.G * NWAVES, lane = F.lane;
    for (int r = gw; r < NTOK; r += NGW) {
        const bf16* ff = F.FF + (size_t)r * D + 4 * lane; const bf16* x1 = F.X1 + (size_t)r * D + 4 * lane;
        const float* md = F.mods + (size_t)cond_of(r) * MODC;
        f32x4 v[16]; unsigned long long xw[16]; float ss = 0.f;
#pragma unroll
        for (int j = 0; j < 16; ++j) { v[j] = ld4bf(ff + 256 * j); xw[j] = *(const unsigned long long*)(x1 + 256 * j); }
#pragma unroll
        for (int j = 0; j < 16; ++j) ss += (v[j].x * v[j].x + v[j].y * v[j].y) + (v[j].z * v[j].z + v[j].w * v[j].w);
        const float rstd = rsqrtf(wave_sum(ss) * (1.f / D) + EPS);
#pragma unroll
        for (int jb = 0; jb < 16; jb += 4) { f32x4 w[4], g[4];
#pragma unroll
            for (int q = 0; q < 4; ++q) { const int col = 4 * (lane + 64 * (jb + q)); w[q] = *(const f32x4*)(F.n_ffn_post + col); g[q] = *(const f32x4*)(md + 5 * D + col); }
            __builtin_amdgcn_sched_barrier(0);
#pragma unroll
            for (int q = 0; q < 4; ++q) { const int j = jb + q, col = 4 * (lane + 64 * j); const unsigned xl = (unsigned)xw[j], xh = (unsigned)(xw[j] >> 32);
                const f32x4 x = (f32x4){bflo(xl), bfhi(xl), bflo(xh), bfhi(xh)};
                __builtin_nontemporal_store(x + g[q] * (v[j] * rstd * w[q]), (f32x4*)(F.out + O_Y + (size_t)r * D + col)); }
            __builtin_amdgcn_sched_barrier(0); }
    }
}
struct StateOrder { int G, c;
    __device__ bool next(int i, pg8::Unit& u) const { const int idx = i * G + c; if (idx >= 512) return false; u.pm = idx; u.pn = idx >> 1; return true; }
    __device__ __forceinline__ void a_ready(const pg8::Unit&) const {}
    __device__ __forceinline__ void done(const pg8::Unit&) const {}
};
struct EpiState { static constexpr bool PERM = false, AFTER_DRAIN = false; float* out;
    __device__ __forceinline__ void operator()(const pg8::f32x4 (&acc)[2][2][4][2], const pg8::Unit& u, int wr, int wc, int fr, int fq) const {
        int loff = (wr * 64 + fr) * 256 + wc * 32 + 4 * fq; asm volatile("" : "+v"(loff));
        float* base = out + ((u.pm & 1) ? O_SB : O_SF) + (size_t)u.pn * 65536 + loff;
#pragma unroll
        for (int ai = 0; ai < 2; ++ai)
#pragma unroll
            for (int m = 0; m < 4; ++m) { float* rowp = base + (ai * pg8::HALF + m * 16) * 256;
#pragma unroll
                for (int bj = 0; bj < 2; ++bj)
#pragma unroll
                    for (int n = 0; n < 2; ++n) __builtin_nontemporal_store(acc[ai][bj][m][n], (pg8::f32x4*)(rowp + bj * pg8::HALF + n * 16)); }
    }
};
struct EpiSwiglu { static constexpr bool PERM = true, AFTER_DRAIN = false; bf16* O;
    __device__ __forceinline__ void operator()(const pg8::f32x4 (&acc)[2][2][4][2], const pg8::Unit& u, int wr, int wc, int fr, int fq) const {
        int loff = (u.pm * pg8::BM + wr * 64 + fr) * FFN + u.pn * 128 + wc * 32 + 8 * fq; asm volatile("" : "+v"(loff));
        bf16* base = O + loff;
#pragma unroll
        for (int ai = 0; ai < 2; ++ai)
#pragma unroll
            for (int m = 0; m < 4; ++m) { const pg8::f32x4 a0 = acc[ai][0][m][0], a1 = acc[ai][0][m][1], b0 = acc[ai][1][m][0], b1 = acc[ai][1][m][1];
                v4u w; w.x = pk2(silu_f(a0[0]) * b0[0], silu_f(a0[1]) * b0[1]); w.y = pk2(silu_f(a0[2]) * b0[2], silu_f(a0[3]) * b0[3]);
                w.z = pk2(silu_f(a1[0]) * b1[0], silu_f(a1[1]) * b1[1]); w.w = pk2(silu_f(a1[2]) * b1[2], silu_f(a1[3]) * b1[3]);
                *(v4u*)(base + (size_t)(ai * pg8::HALF + m * 16) * FFN) = w; }
    }
};
template <bool ADD> struct EpiGate { static constexpr bool PERM = true, AFTER_DRAIN = false; bf16* O; const bf16* gate; const bf16* add;
    __device__ __forceinline__ void operator()(const pg8::f32x4 (&acc)[2][2][4][2], const pg8::Unit& u, int wr, int wc, int fr, int fq) const {
        const int row0 = u.pm * pg8::BM + wr * 64 + fr, col0 = u.pn * pg8::BM + wc * 32 + 8 * fq;
#pragma unroll
        for (int ai = 0; ai < 2; ++ai) {
            v4u gv[4][2], tv[4][2];
#pragma unroll
            for (int m = 0; m < 4; ++m)
#pragma unroll
                for (int bj = 0; bj < 2; ++bj) { const size_t r = (size_t)(row0 + ai * pg8::HALF + m * 16); const int c = col0 + bj * pg8::HALF;
                    gv[m][bj] = *(const v4u*)(gate + r * INC + c); if (ADD) tv[m][bj] = *(const v4u*)(add + r * D + c); }
            __builtin_amdgcn_sched_barrier(0);
#pragma unroll
            for (int m = 0; m < 4; ++m)
#pragma unroll
                for (int bj = 0; bj < 2; ++bj) { const size_t r = (size_t)(row0 + ai * pg8::HALF + m * 16); const int c = col0 + bj * pg8::HALF; float g[8], t[8], o[8];
                    unpack8(gv[m][bj], g);
                    if (ADD) unpack8(tv[m][bj], t);
                    const pg8::f32x4 v0 = acc[ai][bj][m][0], v1 = acc[ai][bj][m][1];
#pragma unroll
                    for (int e = 0; e < 4; ++e) { o[e] = sigm_f(g[e]) * v0[e]; o[4 + e] = sigm_f(g[4 + e]) * v1[e]; }
                    if (ADD) {
#pragma unroll
                        for (int e = 0; e < 8; ++e) o[e] += t[e]; }
                    *(v4u*)(O + r * D + c) = pack8(o); }
            __builtin_amdgcn_sched_barrier(0);
        }
    }
};
struct BlockOrder { int nfull, nblk, x, l, rev;
    __device__ void init(int nN, int c, int rev_ = 0) { nfull = nN / 4; nblk = 6 * nfull + ((nN & 3) ? 3 : 0); x = c & 7; l = c >> 3; rev = rev_; }
    __device__ bool next(int i, pg8::Unit& u) const { const int k = i * 8 + x; if (k >= nblk) return false;
        if (k < 6 * nfull) { int cb = k / 6; const int rb = k - 6 * cb; if (rev) cb = nfull - 1 - cb; u.pm = 8 * rb + (l & 7); u.pn = 4 * cb + (l >> 3); }
        else { const int rb = k - 6 * nfull; u.pm = 16 * rb + (l & 15); u.pn = 4 * nfull + (l >> 4); }
        return true; }
    __device__ __forceinline__ void a_ready(const pg8::Unit&) const {}
    __device__ __forceinline__ void done(const pg8::Unit&) const {}
};
struct Args { const float* in[24]; float* out; unsigned char* ws; int ph_lo, ph_hi, flags, pad; };
__global__ void __launch_bounds__(NTHR, 2) mk_fwd(Args args) {
    extern __shared__ __attribute__((aligned(16))) unsigned char lds[];
    Frame F;
    F.lds = (LAS unsigned char*)lds;
    F.MISC = (volatile LAS unsigned*)(F.lds + MISC_OFF);
    F.tid = threadIdx.x; F.lane = F.tid & 63; F.wave = __builtin_amdgcn_readfirstlane(F.tid >> 6);
    F.G = gridDim.x; F.vcu = blockIdx.x; F.flags = args.flags;
    unsigned char* ws = args.ws;
    F.ctl = (gu32*)(ws + WS_CTL);
    F.xp = args.in[0]; F.xs = args.in[1]; F.cache_k = args.in[2]; F.cache_v = args.in[3]; F.st_f = args.in[4]; F.st_b = args.in[5]; F.c = args.in[6]; F.c_ctx = args.in[7];
    F.w_mod = args.in[8]; F.b_mod = args.in[9]; F.n_mix_pre = args.in[10]; F.n_mix_post = args.in[11]; F.n_ffn_pre = args.in[12]; F.n_ffn_post = args.in[13];
    F.w_in = args.in[14]; F.ld_f = args.in[15]; F.ld_b = args.in[16]; F.gn_w = args.in[17]; F.sink = args.in[18]; F.w_br = args.in[19]; F.w_ba = args.in[20];
    F.w_out = args.in[21]; F.w_up = args.in[22]; F.w_dn = args.in[23]; F.out = args.out;
    F.mods = (float*)(ws + WS_MODS); F.mpart = (float*)(ws + WS_MPART);
    F.Win_t = (bf16*)(ws + WS_WIN); F.Wbr_t = (bf16*)(ws + WS_WBR); F.Wba_t = (bf16*)(ws + WS_WBA); F.Wout_t = (bf16*)(ws + WS_WOUT); F.Wup_t = (bf16*)(ws + WS_WUP); F.Wdn_t = (bf16*)(ws + WS_WDN);
    F.P = (bf16*)(ws + WS_R1); F.MO = (bf16*)(ws + WS_R1); F.UA = (bf16*)(ws + WS_R1); F.UB = F.UA + (size_t)NTOK * FFN;
    F.H1 = (bf16*)(ws + WS_R2); F.OF = (float*)(ws + WS_R2); F.OB = F.OF + (size_t)NTOK * 2048; F.T1 = (bf16*)(ws + WS_R2); F.T2 = F.T1 + (size_t)NTOK * D; F.X1 = (bf16*)(ws + WS_R2);
    F.RO = (bf16*)(ws + WS_R3); F.AO = F.RO + (size_t)NTOK * 2048; F.MIX = F.RO + (size_t)NTOK * D; F.H2 = (bf16*)(ws + WS_R3); F.FF = (bf16*)(ws + WS_R3 + 96 * MiB);
    F.VTRC = (bf16*)(ws + WS_R2); F.VTRL = (bf16*)(ws + WS_R2 + 32 * MiB); F.KT = (bf16*)(ws + WS_R2 + 48 * MiB); F.S0TF = (bf16*)(ws + WS_R2 + 176 * MiB); F.S0TB = (bf16*)(ws + WS_R2 + 180 * MiB);
    F.VT = (bf16*)(ws + WS_R3 + 96 * MiB); F.CK = (bf16*)(ws + WS_R3 + 112 * MiB); F.CVT = (bf16*)(ws + WS_R3 + 116 * MiB);
    for (int u = F.tid; u < (LDS_BYTES - LDSCTL_OFF) / 4; u += NTHR) ((LAS unsigned*)(F.lds + LDSCTL_OFF))[u] = 0u;
    __syncthreads();
    XcdBarrier bar; bar.bar = (unsigned*)(F.ctl + CW_BAR); bar.x = 0; bar.st = nullptr;
    if (MK_ONE_LAUNCH) bar = xcd_barrier_post((unsigned*)(F.ctl + CW_BAR), F.MISC + 8);
    const int lo = args.ph_lo, hi = args.ph_hi;
#define IN(k) (lo <= (k) && (k) < hi)
#define SEAM(k) do { if (IN(k) && IN((k) + 1)) xcd_barrier(bar); } while (0)
    if (IN(0)) { ph_mods_partial(F, 0, 4, F.vcu, F.G); ph_convert(F, 0, F.vcu, F.G); ph_cache(F); ph_s0t(F); } SEAM(0);
    if (IN(2)) { ph_h1(F); } SEAM(2);
    if (IN(3)) { pg8::Gemm g{F.H1, F.Win_t, NTOK, INC, D}; pg8::EpiBf16<0> E{F.P, INC, nullptr, 0, 0, 1.f};
        if (F.G == 256) { BlockOrder S; S.init(INC / 256, (int)blockIdx.x, 1); pg8::gemm_phase<pg8::EpiBf16<0>, BlockOrder, true, true>(F.lds, g, S, E);
            constexpr int lastx = (6 * (INC / 1024)) % 8; const int x = (int)blockIdx.x & 7, l = (int)blockIdx.x >> 3;
            if (x >= lastx) { const int rank = (x - lastx) * 32 + l, n = (8 - lastx) * 32; ph_mods_partial(F, 4, 10, rank, n); ph_convert(F, 1, rank, n); } }
        else { pg8::StaticOrder S; S.init(NTOK, INC, F.G, (int)blockIdx.x); pg8::gemm_phase<pg8::EpiBf16<0>, pg8::StaticOrder, true, true>(F.lds, g, S, E); ph_mods_partial(F, 4, 10, F.vcu, F.G); ph_convert(F, 1, F.vcu, F.G); } } SEAM(3);
    if (IN(4)) { ph_post(F); }
    if (IN(8)) { ph_transposes(F); } if (IN(8) && IN(5)) xcd_barrier(bar);
    if (IN(5)) { ph_retention(F); }
    if (IN(6)) { { pg8::Gemm g{F.KT, F.VTRC, 512 * 256, 256 * 256, 256}; StateOrder S{F.G, (int)blockIdx.x}; EpiState E{F.out};
          pg8::gemm_phase<EpiState, StateOrder, true, true>(F.lds, g, S, E); }
        ph_attention(F); } SEAM(6);
    if (IN(7)) {
        { pg8::Gemm g{F.RO, F.Wbr_t, NTOK, D, 2048}; pg8::StaticOrder S; S.init(NTOK, D, F.G, (int)blockIdx.x); EpiGate<false> E{F.T1, F.P + C_GR, nullptr};
          pg8::gemm_phase<EpiGate<false>, pg8::StaticOrder, true, true>(F.lds, g, S, E); }
        { pg8::Gemm g{F.AO, F.Wba_t, NTOK, D, 2048}; pg8::StaticOrder S; S.init(NTOK, D, F.G, (int)blockIdx.x); EpiGate<true> E{F.MIX, F.P + C_GA, F.T1};
          pg8::gemm_phase<EpiGate<true>, pg8::StaticOrder, true, true>(F.lds, g, S, E); } } SEAM(7);
    if (IN(9)) { pg8::Gemm g{F.MIX, F.Wout_t, NTOK, D, D}; pg8::StaticOrder S; S.init(NTOK, D, F.G, (int)blockIdx.x); pg8::EpiBf16<0> E{F.MO, D, nullptr, 0, 0, 1.f};
        pg8::gemm_phase<pg8::EpiBf16<0>, pg8::StaticOrder, true, true>(F.lds, g, S, E); } SEAM(9);
    if (IN(10)) { ph_rowA(F); } SEAM(10);
    if (IN(11)) { pg8::Gemm g{F.H2, F.Wup_t, NTOK, 2 * FFN, D}; EpiSwiglu E{F.UA};
        if (F.G == 256) { BlockOrder S; S.init(2 * FFN / 256, (int)blockIdx.x); pg8::gemm_phase<EpiSwiglu, BlockOrder, true, true>(F.lds, g, S, E);
            constexpr int nblk = 6 * (2 * FFN / 1024) + (((2 * FFN / 256) & 3) ? 3 : 0), lastx = nblk % 8; const int x = (int)blockIdx.x & 7, l = (int)blockIdx.x >> 3;
            if (x >= lastx) { const int rank = (x - lastx) * 32 + l, n = (8 - lastx) * 32; ph_mods_partial(F, 10, 12, rank, n); ph_convert(F, 2, rank, n); } }
        else { pg8::StaticOrder S; S.init(NTOK, 2 * FFN, F.G, (int)blockIdx.x); pg8::gemm_phase<EpiSwiglu, pg8::StaticOrder, true, true>(F.lds, g, S, E); ph_mods_partial(F, 10, 12, F.vcu, F.G); ph_convert(F, 2, F.vcu, F.G); } } SEAM(11);
    if (IN(13)) { pg8::Gemm g{F.UA, F.Wdn_t, NTOK, D, FFN}; pg8::StaticOrder S; S.init(NTOK, D, F.G, (int)blockIdx.x); pg8::EpiBf16<0> E{F.FF, D, nullptr, 0, 0, 1.f};
        pg8::gemm_phase<pg8::EpiBf16<0>, pg8::StaticOrder, true, true>(F.lds, g, S, E); } SEAM(13);
    if (IN(14)) { ph_rowB(F); }
#undef IN
#undef SEAM
}

extern "C" void kernel_launch(void* const* d_in, const int* in_sizes, int n_in, void* d_out, int out_size, void* d_ws, size_t ws_size, hipStream_t stream) {
    static int grid = 0;
    if (grid == 0) {
        if (n_in != 24 || out_size != (int)O_END || ws_size < WS_END) { fprintf(stderr, "kernel_launch: unexpected shapes (n_in %d out %d ws %zu)\n", n_in, out_size, ws_size); grid = -1; return; }
        int dev = 0, cus = 0, per_cu = 0;
        if (hipGetDevice(&dev) != hipSuccess || hipDeviceGetAttribute(&cus, hipDeviceAttributeMultiprocessorCount, dev) != hipSuccess) { grid = -1; return; }
        if (hipFuncSetAttribute((const void*)mk_fwd, hipFuncAttributeMaxDynamicSharedMemorySize, LDS_BYTES) != hipSuccess) { grid = -1; return; }
        if (hipOccupancyMaxActiveBlocksPerMultiprocessor(&per_cu, (const void*)mk_fwd, NTHR, LDS_BYTES) != hipSuccess || per_cu < 1) { fprintf(stderr, "kernel_launch: occupancy query says %d\n", per_cu); }
        (void)hipGetLastError();
        grid = cus;
        if (grid != 256) { fprintf(stderr, "kernel_launch: expected 256 CUs, got %d\n", grid); }
    }
    if (grid < 0) return;
    (void)hipMemsetAsync((char*)d_ws + WS_CTL, 0, CTL_ZERO_BYTES, stream);
    Args a{};
    for (int i = 0; i < 24; ++i) a.in[i] = (const float*)d_in[i];
    a.out = (float*)d_out; a.ws = (unsigned char*)d_ws;
#if MK_ONE_LAUNCH
    a.ph_lo = 0; a.ph_hi = NPHASE;
    hipLaunchKernelGGL(mk_fwd, dim3(grid), dim3(NTHR), LDS_BYTES, stream, a);
#else
    for (int p = 0; p < NPHASE; ++p) { a.ph_lo = p; a.ph_hi = p + 1; hipLaunchKernelGGL(mk_fwd, dim3(grid), dim3(NTHR), LDS_BYTES, stream, a); }
#endif
}
```
